# Optimizing an MI355X kernel written in HIP

```python
import math
import jax, jax.numpy as jnp
from jax import lax
import numpy as np

D_MODEL = 1024
BATCH = 8
SEQ = 4096
DEPTH = 1

HEAD_DIM = 64
RWKV_HEADS = 8
ATTN_HEADS = 8
RWKV_WIDTH = RWKV_HEADS * HEAD_DIM
ATTN_WIDTH = ATTN_HEADS * HEAD_DIM
D_MIX = RWKV_WIDTH + ATTN_WIDTH
DECAY_RANK = 64
ICLR_RANK = 64
MOBA_BLOCK = 256
MOBA_TOPK = 3
Q_CHUNK = 32
RMS_EPS = 1e-6
GN_EPS = 64e-5
NEG = -1e30

N_RWKV_COLS = 3 * RWKV_WIDTH + DECAY_RANK + ICLR_RANK
N_ATTN_COLS = 3 * ATTN_WIDTH
D_IN_PROJ = N_RWKV_COLS + N_ATTN_COLS + D_MIX
RWKV_SPLITS = (RWKV_WIDTH, 2 * RWKV_WIDTH, 3 * RWKV_WIDTH, 3 * RWKV_WIDTH + DECAY_RANK)

kernel_name = "hymba_rwkv7_moba_alibi_sandwich"


def rms_norm(x, g):
    xf = x.astype(jnp.float32)
    y = xf * lax.rsqrt(jnp.mean(xf * xf, axis=-1, keepdims=True) + RMS_EPS)
    return (y * g.astype(jnp.float32)).astype(x.dtype)


def _rwkv7_step(S, inp):
    r_t, w_t, k_t, v_t, a_t, b_t = inp
    Sa = jnp.einsum('bhij,bhj->bhi', S, a_t)
    S = S * w_t[:, :, None, :] + Sa[..., None] * b_t[:, :, None, :] + v_t[..., None] * k_t[:, :, None, :]
    y = jnp.einsum('bhij,bhj->bhi', S, r_t)
    return S, y


def rwkv7_time_mix(p, mu, w0, w2, a0, a2, k_k, k_a, r_k, lnx_w, lnx_b):
    B, T, _ = p.shape
    H, N = RWKV_HEADS, HEAD_DIM
    f32 = jnp.float32
    p_prev = jnp.pad(p, ((0, 0), (1, 0), (0, 0)))[:, :T]
    p = p + (p_prev - p) * mu
    r, k, v, wd, ad = jnp.split(p, RWKV_SPLITS, axis=-1)
    w = -jax.nn.softplus(-(w0 + jnp.tanh(wd) @ w2)) - 0.5
    decay = jnp.exp(-jnp.exp(w.astype(f32)))
    a = jax.nn.sigmoid(a0 + ad @ a2)
    kk = (k * k_k).astype(f32).reshape(B, T, H, N)
    kk = kk / jnp.maximum(jnp.linalg.norm(kk, axis=-1, keepdims=True), 1e-12)
    k = k * (1 + (a - 1) * k_a)
    heads = lambda z: z.astype(f32).reshape(B, T, H, N)
    r_h, k_h, v_h, w_h, a_h = heads(r), heads(k), heads(v), heads(decay), heads(a)
    vec_a = -kk
    vec_b = kk * a_h
    tm = lambda z: jnp.moveaxis(z, 1, 0)
    S0 = jnp.zeros((B, H, N, N), f32)
    _, y = lax.scan(_rwkv7_step, S0, (tm(r_h), tm(w_h), tm(k_h), tm(v_h), tm(vec_a), tm(vec_b)))
    y = jnp.moveaxis(y, 0, 1)
    mean = jnp.mean(y, axis=-1, keepdims=True)
    var = jnp.mean(jnp.square(y - mean), axis=-1, keepdims=True)
    y = (y - mean) * lax.rsqrt(var + GN_EPS)
    y = y.reshape(B, T, H * N) * lnx_w.astype(f32) + lnx_b.astype(f32)
    bonus = jnp.sum(r_h * k_h * r_k.astype(f32), axis=-1, keepdims=True) * v_h
    y = y + bonus.reshape(B, T, H * N)
    return y.astype(p.dtype)


def moba_attention(q, k, v):
    B, T, _ = q.shape
    H, Dh, BS = ATTN_HEADS, HEAD_DIM, MOBA_BLOCK
    f32 = jnp.float32
    nb = -(-T // BS)
    tp = nb * BS
    topk = min(MOBA_TOPK, nb)
    C = Q_CHUNK
    nc = T // C
    q = q.reshape(B, T, H, Dh).transpose(0, 2, 1, 3) * (Dh ** -0.5)
    to_heads = lambda z: jnp.pad(z.reshape(B, T, H, Dh).transpose(0, 2, 1, 3),
                                 ((0, 0), (0, 0), (0, tp - T), (0, 0)))
    kp, vp = to_heads(k), to_heads(v)
    kb = kp.reshape(B, H, nb, BS, Dh)
    vb = vp.reshape(B, H, nb, BS, Dh)
    k_mean = jnp.mean(kb.astype(f32), axis=3)
    t_pos = jnp.arange(T)
    q_blk = t_pos // BS
    gate = jnp.einsum('bhtd,bhnd->bhtn', q.astype(f32), k_mean)
    past = jnp.arange(nb)[None, :] < q_blk[:, None]
    gate = jnp.where(past, gate, NEG)
    _, sel = lax.top_k(gate, topk)
    slopes = 2.0 ** (-8.0 * jnp.arange(1, H + 1, dtype=f32) / H)
    q_c = q.reshape(B, H, nc, C, Dh).transpose(2, 0, 1, 3, 4)
    sel_c = sel.reshape(B, H, nc, C, topk).transpose(2, 0, 1, 3, 4)
    b_ix = jnp.arange(B)[:, None, None, None]
    h_ix = jnp.arange(H)[None, :, None, None]

    def chunk(args):
        qc, sc, ci = args
        t = ci * C + jnp.arange(C)
        ob = (ci * C) // BS
        k_sel = kb[b_ix, h_ix, sc]
        v_sel = vb[b_ix, h_ix, sc]
        s_sel = sc[..., None] * BS + jnp.arange(BS)
        lg_sel = jnp.einsum('bhcd,bhcksd->bhcks', qc, k_sel).astype(f32)
        lg_sel = lg_sel - slopes[None, :, None, None, None] * (t[:, None, None] - s_sel).astype(f32)
        valid = jnp.arange(topk)[None, :] < (t // BS)[:, None]
        lg_sel = jnp.where(valid[:, :, None], lg_sel, NEG)
        k_own = lax.dynamic_slice_in_dim(kp, ob * BS, BS, axis=2)
        v_own = lax.dynamic_slice_in_dim(vp, ob * BS, BS, axis=2)
        s_own = ob * BS + jnp.arange(BS)
        lg_own = jnp.einsum('bhcd,bhsd->bhcs', qc, k_own).astype(f32)
        lg_own = lg_own - slopes[:, None, None] * (t[:, None] - s_own[None, :]).astype(f32)
        lg_own = jnp.where(s_own[None, :] <= t[:, None], lg_own, NEG)
        logits = jnp.concatenate([lg_sel.reshape(B, H, C, topk * BS), lg_own], axis=-1)
        prob = jax.nn.softmax(logits, axis=-1)
        p_sel = prob[..., :topk * BS].reshape(B, H, C, topk, BS).astype(vb.dtype)
        p_own = prob[..., topk * BS:].astype(vb.dtype)
        return (jnp.einsum('bhcks,bhcksd->bhcd', p_sel, v_sel)
                + jnp.einsum('bhcs,bhsd->bhcd', p_own, v_own))

    o = lax.map(chunk, (q_c, sel_c, jnp.arange(nc)))
    return o.transpose(1, 0, 3, 2, 4).reshape(B, T, H * Dh)


def setup_inputs(seed: int = 0) -> dict:
    key = jax.random.key(seed)
    ks = jax.random.split(key, 16)
    L, D = DEPTH, D_MODEL
    nrm = jax.random.normal
    return {
        "x": nrm(ks[0], (BATCH, SEQ, D), jnp.float32),
        "g_pre": 1.0 + 0.05 * nrm(ks[1], (L, D), jnp.float32),
        "w_in": nrm(ks[2], (L, D, D_IN_PROJ), jnp.float32) * D ** -0.5,
        "tshift_mu": jax.random.uniform(ks[3], (L, N_RWKV_COLS), jnp.float32),
        "w0": jax.random.uniform(ks[4], (L, RWKV_WIDTH), jnp.float32, -6.0, 1.0),
        "w2": nrm(ks[5], (L, DECAY_RANK, RWKV_WIDTH), jnp.float32) * 0.5 * DECAY_RANK ** -0.5,
        "a0": 0.1 * nrm(ks[6], (L, RWKV_WIDTH), jnp.float32),
        "a2": nrm(ks[7], (L, ICLR_RANK, RWKV_WIDTH), jnp.float32) * 0.5 * ICLR_RANK ** -0.5,
        "k_k": 0.85 + 0.05 * nrm(ks[8], (L, RWKV_WIDTH), jnp.float32),
        "k_a": 1.0 + 0.05 * nrm(ks[9], (L, RWKV_WIDTH), jnp.float32),
        "r_k": 0.1 * nrm(ks[10], (L, RWKV_HEADS, HEAD_DIM), jnp.float32),
        "lnx_w": 1.0 + 0.05 * nrm(ks[11], (L, RWKV_WIDTH), jnp.float32),
        "lnx_b": 0.02 * nrm(ks[12], (L, RWKV_WIDTH), jnp.float32),
        "w_out": nrm(ks[13], (L, D_MIX, D), jnp.float32) * D_MIX ** -0.5,
        "g_post": 1.0 + 0.05 * nrm(ks[14], (L, D), jnp.float32),
    }


def reference(x, g_pre, w_in, tshift_mu, w0, w2, a0, a2, k_k, k_a, r_k, lnx_w, lnx_b, w_out, g_post):
    for l in range(DEPTH):
        h = rms_norm(x, g_pre[l])
        proj = h @ w_in[l]
        p_rwkv = proj[..., :N_RWKV_COLS]
        p_attn = proj[..., N_RWKV_COLS:N_RWKV_COLS + N_ATTN_COLS]
        gates = proj[..., N_RWKV_COLS + N_ATTN_COLS:]
        y_r = rwkv7_time_mix(p_rwkv, tshift_mu[l], w0[l], w2[l], a0[l], a2[l],
                             k_k[l], k_a[l], r_k[l], lnx_w[l], lnx_b[l])
        q, k, v = jnp.split(p_attn, 3, axis=-1)
        y_a = moba_attention(q, k, v)
        y = jnp.concatenate([y_r, y_a], axis=-1) * jax.nn.silu(gates)
        o = y @ w_out[l]
        x = x + rms_norm(o, g_post[l])
    return x
```

```cpp
#include <hip/hip_runtime.h>
#include <cstdio>
#include <cstdint>
#include <cmath>
namespace pg8 {
#define PG8_LAS __attribute__((address_space(3)))
typedef unsigned short bf16_t;
typedef short bf16x8 __attribute__((ext_vector_type(8)));
typedef float f32x4 __attribute__((ext_vector_type(4)));
typedef unsigned u32x4 __attribute__((ext_vector_type(4)));
constexpr int BM = 256, BK = 64, HALF = 128, HTB = HALF * BK * 2  , STAGE_BYTES = 8 * HTB, NXCD = 8, WGM = 8;

__host__ __device__ __forceinline__ int lds_byte(int r, int c) { const int st = (r >> 4) * 2 + (c >> 5), rr = r & 15, cc = c & 31, ob = rr * 64 + cc * 2; return st * 1024 + (ob ^ (((ob >> 9) & 1) << 5)); }
__host__ __device__ __forceinline__ void stage_rc(int b, int& R, int& C) { const int st = b / 1024, sb = b % 1024, swz = sb ^ (((sb >> 9) & 1) << 5); R = (st >> 1) * 16 + swz / 64; C = (st & 1) * 32 + (swz % 64) / 2; }
__host__ __device__ __forceinline__ int perm32(int rho) { const int n = rho >> 4, i = rho & 15; return 8 * (i >> 2) + 4 * n + (i & 3); }

struct Unit { int pm, pn; };
struct Gemm { const bf16_t* A; const bf16_t* Bt; int M, N, K; };

struct StaticOrder {
    int nM, nN, nwg, G, c;
    __host__ __device__ void init(int M, int N, int G_, int c_) { nM = M / BM; nN = N / BM; nwg = nM * nN; G = G_; c = c_; }
    __host__ __device__ bool next(int i, Unit& u) const {
        const long L = (long)i * G + c; if (L >= nwg) return false;
        int wgid = (int)L; { const int q = nwg / NXCD, r = nwg % NXCD, xcd = wgid % NXCD, off = wgid / NXCD; wgid = (xcd < r ? xcd * (q + 1) : r * (q + 1) + (xcd - r) * q) + off; }
        const int nig = WGM * nN, gid = wgid / nig, fm = gid * WGM, gsz = (nM - fm) < WGM ? (nM - fm) : WGM;
        u.pm = fm + ((wgid % nig) % gsz); u.pn = (wgid % nig) / gsz; return true;
    }
    __device__ __forceinline__ void a_ready(const Unit&) const {}
    __device__ __forceinline__ void done(const Unit&) const {}
};

__device__ __forceinline__ unsigned cvt_pk_bf16(float lo, float hi) { unsigned r; asm volatile("v_cvt_pk_bf16_f32 %0, %1, %2" : "=v"(r) : "v"(lo), "v"(hi)); return r; }
typedef float f32x2 __attribute__((ext_vector_type(2)));
__device__ __forceinline__ f32x2 gelu_pk(f32x2 v) {
    const f32x2 av = __builtin_elementwise_abs(v), d = av * 0.2316418882f + 1.0f;
    f32x2 t; t.x = __builtin_amdgcn_rcpf(d.x); t.y = __builtin_amdgcn_rcpf(d.y);
    f32x2 q = t * 0.5307027145f + (-0.7265760135f); q = q * t + 0.7107068705f; q = q * t + (-0.142248368f); q = q * t + 0.127414796f; q = q * t;
    const f32x2 s = (v * v) * (-0.72134752044f);
    f32x2 e; e.x = __builtin_amdgcn_exp2f(s.x); e.y = __builtin_amdgcn_exp2f(s.y);
    const f32x2 m = v * (q * e), r = v - m;
    f32x2 o; o.x = v.x < 0.f ? m.x : r.x; o.y = v.y < 0.f ? m.y : r.y; return o;
}

template <int ACT  > struct EpiBf16 {
    static constexpr bool PERM = true, AFTER_DRAIN = false; static_assert(ACT == 0 || ACT == 1, "EpiBf16: ACT is 0 (none) or 1 (gelu_pk)");
    bf16_t* O; int ldc; const float* bias; int split_cols; size_t split_stride; float scale0;
    __device__ __forceinline__ void operator()(const f32x4 (&acc)[2][2][4][2], const Unit& u, int wr, int wc, int fr, int fq) const {
        const int row0 = u.pm * BM + wr * 64 + fr; int colt = u.pn * BM; bf16_t* base = O;
        float sc = 1.f; if (split_cols) { const int t = colt / split_cols; base += (size_t)t * split_stride; colt -= t * split_cols; if (t == 0) sc = scale0; }
        const int col0 = colt + wc * 32 + 8 * fq, bcol0 = u.pn * BM + wc * 32 + 8 * fq;
        f32x4 bv[2][2];
#pragma unroll
        for (int bj = 0; bj < 2; ++bj)
#pragma unroll
            for (int n = 0; n < 2; ++n) bv[bj][n] = bias ? *(const f32x4*)(bias + bcol0 + bj * HALF + 4 * n) : (f32x4){0.f, 0.f, 0.f, 0.f};
#pragma unroll
        for (int ai = 0; ai < 2; ++ai)
#pragma unroll
            for (int m = 0; m < 4; ++m) { bf16_t* rowp = base + (size_t)(row0 + ai * HALF + m * 16) * ldc + col0;
#pragma unroll
                for (int bj = 0; bj < 2; ++bj) { f32x4 v0 = acc[ai][bj][m][0] + bv[bj][0], v1 = acc[ai][bj][m][1] + bv[bj][1];
                    if (ACT == 1) { f32x2 a = gelu_pk((f32x2){v0[0], v0[1]}), b = gelu_pk((f32x2){v0[2], v0[3]}), c = gelu_pk((f32x2){v1[0], v1[1]}), d = gelu_pk((f32x2){v1[2], v1[3]});
                        v0 = (f32x4){a.x, a.y, b.x, b.y}; v1 = (f32x4){c.x, c.y, d.x, d.y}; }
                    v0 = v0 * sc; v1 = v1 * sc; u32x4 w; w.x = cvt_pk_bf16(v0[0], v0[1]); w.y = cvt_pk_bf16(v0[2], v0[3]); w.z = cvt_pk_bf16(v1[0], v1[1]); w.w = cvt_pk_bf16(v1[2], v1[3]);
                    *(u32x4*)(rowp + bj * HALF) = w; } }
    }
};

struct EpiF32 {
    static constexpr bool PERM = false, AFTER_DRAIN = false;
    float* C; int ldc; const float* bias;
    __device__ __forceinline__ void operator()(const f32x4 (&acc)[2][2][4][2], const Unit& u, int wr, int wc, int fr, int fq) const {
        const int row0 = u.pm * BM + wr * 64 + fr, col0 = u.pn * BM + wc * 32 + 4 * fq;
        f32x4 bv[2][2];
#pragma unroll
        for (int bj = 0; bj < 2; ++bj)
#pragma unroll
            for (int n = 0; n < 2; ++n) bv[bj][n] = bias ? *(const f32x4*)(bias + col0 + bj * HALF + n * 16) : (f32x4){0.f, 0.f, 0.f, 0.f};
#pragma unroll
        for (int ai = 0; ai < 2; ++ai)
#pragma unroll
            for (int m = 0; m < 4; ++m) { float* rowp = C + (size_t)(row0 + ai * HALF + m * 16) * ldc + col0;
#pragma unroll
                for (int bj = 0; bj < 2; ++bj)
#pragma unroll
                    for (int n = 0; n < 2; ++n) *(f32x4*)(rowp + bj * HALF + n * 16) = acc[ai][bj][m][n] + bv[bj][n]; }
    }
};

struct PanelStats {
    unsigned* xbuf;
    unsigned* cnt;
    unsigned* tmo;
    int ntn; float eps;
    unsigned code;
    __device__ __forceinline__ bool run(const f32x4 (&v)[2][2][4][2], const Unit& u, int wr, int wc, int fr, int fq, PG8_LAS unsigned char* lds, int wid, int lane) const {
        typedef float f32x2v __attribute__((ext_vector_type(2)));
        PG8_LAS f32x2v* P = (PG8_LAS f32x2v*)lds;
        PG8_LAS f32x2v* S = (PG8_LAS f32x2v*)(lds + 8192);
        PG8_LAS unsigned* flag = (PG8_LAS unsigned*)(lds + 8192 + 2048);
#pragma unroll
        for (int ai = 0; ai < 2; ++ai)
#pragma unroll
            for (int m = 0; m < 4; ++m) {
                float s = 0.f;
#pragma unroll
                for (int bj = 0; bj < 2; ++bj)
#pragma unroll
                    for (int n = 0; n < 2; ++n) { const f32x4 x = v[ai][bj][m][n]; s += (x[0] + x[1]) + (x[2] + x[3]); }
                s += __shfl_xor(s, 16); s += __shfl_xor(s, 32);
                const float mw = s * (1.0f / 64.0f); float q = 0.f;
#pragma unroll
                for (int bj = 0; bj < 2; ++bj)
#pragma unroll
                    for (int n = 0; n < 2; ++n) { const f32x4 d = v[ai][bj][m][n] - mw; q += (d[0] * d[0] + d[1] * d[1]) + (d[2] * d[2] + d[3] * d[3]); }
                q += __shfl_xor(q, 16); q += __shfl_xor(q, 32);
                if (fq == 0) P[(ai * HALF + wr * 64 + m * 16 + fr) * 4 + wc] = (f32x2v){mw, q};
            }
        asm volatile("s_waitcnt lgkmcnt(0)" ::: "memory"); __builtin_amdgcn_s_barrier(); asm volatile("" ::: "memory");
#if defined(BROKEN_EXCHANGE_NO_WAIT)
#warning BROKEN CONTROL BUILD: the row-statistics exchange does not wait; results are wrong by design
        if (blockIdx.x >= 64) { const long long t0_ = clock64(); while (clock64() - t0_ < 60000) __builtin_amdgcn_s_sleep(8); }
#endif
        const int row = wid * 32 + (lane & 31);
        if (lane < 32) {
            const f32x2v a = P[row * 4 + 0], b = P[row * 4 + 1], c = P[row * 4 + 2], d = P[row * 4 + 3];
            const float mt = (a.x + b.x + c.x + d.x) * 0.25f;
            const float da = a.x - mt, db = b.x - mt, dc = c.x - mt, dd = d.x - mt;
            const float m2 = (a.y + b.y) + (c.y + d.y) + 64.0f * ((da * da + db * db) + (dc * dc + dd * dd));
            unsigned long long* slot = (unsigned long long*)xbuf + ((size_t)(u.pm * BM + row) * 4 + u.pn);
            __hip_atomic_store(slot, ((unsigned long long)__float_as_uint(m2) << 32) | __float_as_uint(mt), __ATOMIC_RELAXED, __HIP_MEMORY_SCOPE_AGENT);
        }
        asm volatile("s_waitcnt vmcnt(0)" ::: "memory");
        if (lane == 0) __hip_atomic_fetch_add(cnt + 64 * u.pm, 1u, __ATOMIC_RELAXED, __HIP_MEMORY_SCOPE_AGENT);
        if (wid == 0) {
            bool dead = false; const unsigned long long t0 = __builtin_amdgcn_s_memrealtime(); const unsigned want = 8u * (unsigned)ntn;
            for (;;) {
#if defined(BROKEN_EXCHANGE_NO_WAIT)
                break;
#endif
                if ((unsigned)__builtin_amdgcn_readfirstlane(__hip_atomic_load(cnt + 64 * u.pm, __ATOMIC_RELAXED, __HIP_MEMORY_SCOPE_AGENT)) >= want) break;
                if (__builtin_amdgcn_s_memrealtime() - t0 > 2000000ull) {
                    if (lane == 0) { unsigned expect = 0u; __hip_atomic_compare_exchange_strong(tmo + 1, &expect, code | (unsigned)(u.pm & 0xff), __ATOMIC_RELAXED, __ATOMIC_RELAXED, __HIP_MEMORY_SCOPE_AGENT);
                                     __hip_atomic_store(tmo, 1u, __ATOMIC_RELAXED, __HIP_MEMORY_SCOPE_AGENT); }
                    dead = true; break; }
                __builtin_amdgcn_s_sleep(2);
            }
            __builtin_amdgcn_fence(__ATOMIC_ACQUIRE, "agent");
            if (lane == 0) flag[0] = dead ? 1u : 0u;
        }
        asm volatile("s_waitcnt vmcnt(0) lgkmcnt(0)" ::: "memory"); __builtin_amdgcn_s_barrier(); asm volatile("" ::: "memory");
        const bool bad = flag[0] != 0u;
        if (lane < 32) {
            const unsigned long long* slot = (const unsigned long long*)xbuf + (size_t)(u.pm * BM + row) * 4; float mt[4], m2[4]; float ms = 0.f;
#pragma unroll
            for (int t = 0; t < 4; ++t) { if (t < ntn) { const unsigned long long w = __hip_atomic_load(slot + t, __ATOMIC_RELAXED, __HIP_MEMORY_SCOPE_AGENT); mt[t] = __uint_as_float((unsigned)w); m2[t] = __uint_as_float((unsigned)(w >> 32)); } else { mt[t] = 0.f; m2[t] = 0.f; } ms += mt[t]; }
            const float mean = ms / (float)ntn; float q = 0.f;
#pragma unroll
            for (int t = 0; t < 4; ++t) if (t < ntn) { const float dm = mt[t] - mean; q += m2[t] + 256.0f * dm * dm; }
            S[row] = (f32x2v){mean, 1.0f / sqrtf(q / (256.0f * (float)ntn) + eps)};
        }
        asm volatile("s_waitcnt lgkmcnt(0)" ::: "memory"); __builtin_amdgcn_s_barrier(); asm volatile("" ::: "memory");
        return bad;
    }
};
struct EpiLnRes {
    static constexpr bool PERM = false, AFTER_DRAIN = true;
    const float* base; float* out; int ldc; const float* bias; PanelStats st; unsigned poison;
    __device__ __forceinline__ void fused(f32x4 (&acc)[2][2][4][2], const Unit& u, int wr, int wc, int fr, int fq, PG8_LAS unsigned char* lds, int wid, int lane) const {
        typedef float f32x2v __attribute__((ext_vector_type(2)));
        const PG8_LAS f32x2v* S = (const PG8_LAS f32x2v*)(lds + 8192);
        const int col0 = u.pn * BM + wc * 32 + 4 * fq;
#pragma unroll
        for (int bj = 0; bj < 2; ++bj)
#pragma unroll
            for (int n = 0; n < 2; ++n) { const f32x4 bv = bias ? *(const f32x4*)(bias + col0 + bj * HALF + n * 16) : (f32x4){0.f, 0.f, 0.f, 0.f};
#pragma unroll
                for (int ai = 0; ai < 2; ++ai)
#pragma unroll
                    for (int m = 0; m < 4; ++m) acc[ai][bj][m][n] += bv; }
        f32x4 pre[4][2][2];
#pragma unroll
        for (int m = 0; m < 4; ++m) { const size_t off = (size_t)(u.pm * BM + wr * 64 + m * 16 + fr) * ldc + col0;
#pragma unroll
            for (int bj = 0; bj < 2; ++bj)
#pragma unroll
                for (int n = 0; n < 2; ++n) pre[m][bj][n] = *(const f32x4*)(base + off + bj * HALF + n * 16); }
        const bool bad = st.run(acc, u, wr, wc, fr, fq, lds, wid, lane) || poison != 0u;
        const float qnan = __builtin_nanf("");
#pragma unroll
        for (int ai = 0; ai < 2; ++ai)
#pragma unroll
            for (int m = 0; m < 4; ++m) { const int r = ai * HALF + wr * 64 + m * 16 + fr; const f32x2v sr = S[r]; const size_t off = (size_t)(u.pm * BM + r) * ldc + col0;
#pragma unroll
                for (int bj = 0; bj < 2; ++bj)
#pragma unroll
                    for (int n = 0; n < 2; ++n) { const f32x4 bs = ai == 0 ? pre[m][bj][n] : *(const f32x4*)(base + off + bj * HALF + n * 16); f32x4 o = bs + (acc[ai][bj][m][n] - sr.x) * sr.y;
                        if (bad) o = (f32x4){qnan, qnan, qnan, qnan}; *(f32x4*)(out + off + bj * HALF + n * 16) = o; }
                if (m & 1) asm volatile("" ::: "memory"); }
    }
};
struct EpiLnResLn {
    static constexpr bool PERM = false, AFTER_DRAIN = true;
    const float* base; float* out; bf16_t* xn; int ldc; const float* bias; PanelStats st1, st2; unsigned poison;
    __device__ __forceinline__ void fused(f32x4 (&acc)[2][2][4][2], const Unit& u, int wr, int wc, int fr, int fq, PG8_LAS unsigned char* lds, int wid, int lane) const {
        typedef float f32x2v __attribute__((ext_vector_type(2))); typedef unsigned u32x2v __attribute__((ext_vector_type(2)));
        const PG8_LAS f32x2v* S = (const PG8_LAS f32x2v*)(lds + 8192);
        const int col0 = u.pn * BM + wc * 32 + 4 * fq;
#pragma unroll
        for (int bj = 0; bj < 2; ++bj)
#pragma unroll
            for (int n = 0; n < 2; ++n) { const f32x4 bv = bias ? *(const f32x4*)(bias + col0 + bj * HALF + n * 16) : (f32x4){0.f, 0.f, 0.f, 0.f};
#pragma unroll
                for (int ai = 0; ai < 2; ++ai)
#pragma unroll
                    for (int m = 0; m < 4; ++m) acc[ai][bj][m][n] += bv; }
        bool bad = st1.run(acc, u, wr, wc, fr, fq, lds, wid, lane) || poison != 0u;
        const float qnan = __builtin_nanf("");
#pragma unroll
        for (int ai = 0; ai < 2; ++ai)
#pragma unroll
            for (int m = 0; m < 4; ++m) { const int r = ai * HALF + wr * 64 + m * 16 + fr; const f32x2v sr = S[r]; const size_t off = (size_t)(u.pm * BM + r) * ldc + col0;
#pragma unroll
                for (int bj = 0; bj < 2; ++bj)
#pragma unroll
                    for (int n = 0; n < 2; ++n) { const f32x4 bs = *(const f32x4*)(base + off + bj * HALF + n * 16); acc[ai][bj][m][n] = bs + (acc[ai][bj][m][n] - sr.x) * sr.y; }
                asm volatile("" : "+v"(acc[ai][0][m][0]), "+v"(acc[ai][0][m][1]), "+v"(acc[ai][1][m][0]), "+v"(acc[ai][1][m][1]));
                if (m & 1) asm volatile("" ::: "memory"); }
        const bool bad1 = bad;
        bad = st2.run(acc, u, wr, wc, fr, fq, lds, wid, lane) || bad;
#pragma unroll
        for (int ai = 0; ai < 2; ++ai)
#pragma unroll
            for (int m = 0; m < 4; ++m) { const int r = ai * HALF + wr * 64 + m * 16 + fr; const f32x2v sr = S[r]; const size_t off = (size_t)(u.pm * BM + r) * ldc + col0;
#pragma unroll
                for (int bj = 0; bj < 2; ++bj)
#pragma unroll
                    for (int n = 0; n < 2; ++n) { const f32x4 x1 = acc[ai][bj][m][n]; *(f32x4*)(out + off + bj * HALF + n * 16) = bad1 ? (f32x4){qnan, qnan, qnan, qnan} : x1;
                        const f32x4 o = (x1 - sr.x) * sr.y; u32x2v w; w.x = cvt_pk_bf16(o[0], o[1]); w.y = cvt_pk_bf16(o[2], o[3]);
                        if (bad) { w.x = 0x7fc07fc0u; w.y = 0x7fc07fc0u; } *(u32x2v*)(xn + off + bj * HALF + n * 16) = w; }
                asm volatile("" ::: "memory"); }
    }
};

template <class Epi, class Sched, bool ALIGN_EPI = false, bool SP2 = false>
__device__ __forceinline__ void gemm_phase(PG8_LAS unsigned char* lds, const Gemm g, const Sched& S, const Epi& E) {
    const int tid = threadIdx.x, wid = __builtin_amdgcn_readfirstlane(tid >> 6), lane = tid & 63, wr = wid >> 2, wc = wid & 3, fr = lane & 15, fq = lane >> 4;
    const int K = g.K, nt = K / BK;
    unsigned voffA[2], voffB[2];
#pragma unroll
    for (int i = 0; i < 2; ++i) { int R, C; stage_rc(tid * 16 + i * 8192, R, C); const int Rb = Epi::PERM ? ((R & ~31) + perm32(R & 31)) : R;
        voffA[i] = (unsigned)(R * K + C) * 2u; voffB[i] = (unsigned)(Rb * K + C) * 2u; }
    const size_t kstep = (size_t)(BK * 2);
    const size_t hstep = (size_t)HALF * K * 2;
    const size_t tstep = 2 * hstep;
    const unsigned ldsw = (unsigned)wid * 1024u;
    const int aoff = lds_byte(wr * 64 + fr, fq * 8), boff = lds_byte(wc * 32 + fr, fq * 8);
#define PG8_SA(b, h) (((b) * 2 + (h)) * HTB)
#define PG8_SB(b, h) ((4 + (b) * 2 + (h)) * HTB)
#define PG8_STAGE(bufoff, gbase, voff) do { _Pragma("unroll") for (int _i = 0; _i < 2; ++_i) \
        __builtin_amdgcn_global_load_lds((const unsigned*)((const char*)(gbase) + (voff)[_i]), (PG8_LAS unsigned*)(lds + (bufoff) + ldsw + _i * 8192), 16, 0, 0); } while (0)
#define PG8_LDA(dst, b, h) do { _Pragma("unroll") for (int m = 0; m < 4; ++m) _Pragma("unroll") for (int k = 0; k < 2; ++k) dst[m][k] = *(const PG8_LAS bf16x8*)(lds + PG8_SA(b, h) + aoff + m * 2048 + k * 1024); } while (0)
#define PG8_LDB(dst, b, h) do { _Pragma("unroll") for (int n = 0; n < 2; ++n) _Pragma("unroll") for (int k = 0; k < 2; ++k) dst[n][k] = *(const PG8_LAS bf16x8*)(lds + PG8_SB(b, h) + boff + n * 2048 + k * 1024); } while (0)
#define PG8_MMA(ai, bj, At, Bt) do { __builtin_amdgcn_s_setprio(1); _Pragma("unroll") for (int m = 0; m < 4; ++m) _Pragma("unroll") for (int n = 0; n < 2; ++n) _Pragma("unroll") for (int k = 0; k < 2; ++k) \
        acc[ai][bj][m][n] = __builtin_amdgcn_mfma_f32_16x16x32_bf16(Bt[n][k], At[m][k], acc[ai][bj][m][n], 0, 0, 0); __builtin_amdgcn_s_setprio(0); } while (0)
#define PG8_WAIT_V(n) asm volatile("s_waitcnt vmcnt(" #n ")" ::: "memory")
#define PG8_WAIT_L(n) asm volatile("s_waitcnt lgkmcnt(" #n ")" ::: "memory")
#define PG8_BAR __builtin_amdgcn_s_barrier()
#define PG8_SCHED __builtin_amdgcn_sched_barrier(0)
    Unit cur, nxt; int ui = 0;
    if (!S.next(0, cur)) return;
    f32x4 acc[2][2][4][2];
#pragma unroll
    for (int a = 0; a < 2; ++a)
#pragma unroll
        for (int b = 0; b < 2; ++b)
#pragma unroll
            for (int m = 0; m < 4; ++m)
#pragma unroll
                for (int n = 0; n < 2; ++n) acc[a][b][m][n] = (f32x4){0.f, 0.f, 0.f, 0.f};
    bf16x8 At[4][2], B0[2][2], B1[2][2];
    const char* cA = (const char*)g.A + (size_t)cur.pm * tstep; const char* cB = (const char*)g.Bt + (size_t)cur.pn * tstep;
    S.a_ready(cur);
    if constexpr (SP2) {
        PG8_STAGE(PG8_SB(0, 0), cB, voffB); PG8_STAGE(PG8_SB(0, 1), cB + hstep, voffB); PG8_STAGE(PG8_SA(0, 0), cA, voffA); PG8_STAGE(PG8_SA(0, 1), cA + hstep, voffA);
        if (wr == 1) PG8_BAR;
        PG8_WAIT_V(2); PG8_BAR;
        PG8_STAGE(PG8_SB(1, 0), cB + kstep, voffB); PG8_STAGE(PG8_SA(1, 0), cA + kstep, voffA); PG8_STAGE(PG8_SB(1, 1), cB + hstep + kstep, voffB);
        PG8_WAIT_V(6); PG8_BAR;
    } else {
        PG8_STAGE(PG8_SB(0, 0), cB, voffB); PG8_STAGE(PG8_SA(0, 0), cA, voffA); PG8_STAGE(PG8_SB(0, 1), cB + hstep, voffB); PG8_STAGE(PG8_SA(0, 1), cA + hstep, voffA);
        if (wr == 1) PG8_BAR;
        PG8_WAIT_V(4); PG8_BAR;
        PG8_STAGE(PG8_SB(1, 0), cB + kstep, voffB); PG8_STAGE(PG8_SA(1, 0), cA + kstep, voffA); PG8_STAGE(PG8_SB(1, 1), cB + hstep + kstep, voffB);
        PG8_WAIT_V(6); PG8_BAR;
    }
    for (;;) {
        const bool has_next = S.next(ui + 1, nxt);
        const char* nA = has_next ? (const char*)g.A + (size_t)nxt.pm * tstep : cA; const char* nB = has_next ? (const char*)g.Bt + (size_t)nxt.pn * tstep : cB;
        for (int t = 0; t < nt; t += 2) {
            const bool last = (t == nt - 2);
            const char* a1 = cA + (size_t)(t + 1) * kstep;
            const char* a2 = last ? nA : cA + (size_t)(t + 2) * kstep; const char* b2 = last ? nB : cB + (size_t)(t + 2) * kstep;
            const char* a3 = a2 + kstep; const char* b3 = b2 + kstep;
            if (last && has_next) S.a_ready(nxt);
            if constexpr (SP2) {
            PG8_LDB(B0, 0, 0); PG8_LDB(B1, 0, 1); PG8_SCHED; PG8_LDA(At, 0, 0); PG8_STAGE(PG8_SA(1, 1), a1 + hstep, voffA);
            PG8_WAIT_V(8); PG8_WAIT_L(0); PG8_BAR; PG8_MMA(0, 0, At, B0); PG8_MMA(0, 1, At, B1); PG8_BAR; PG8_SCHED;
            PG8_LDA(At, 0, 1); PG8_STAGE(PG8_SB(0, 0), b2, voffB); PG8_STAGE(PG8_SB(0, 1), b2 + hstep, voffB); PG8_STAGE(PG8_SA(0, 0), a2, voffA);
            PG8_WAIT_V(8); PG8_WAIT_L(0); PG8_BAR; PG8_MMA(1, 0, At, B0); PG8_MMA(1, 1, At, B1); PG8_BAR; PG8_SCHED;
            PG8_LDB(B0, 1, 0); PG8_LDB(B1, 1, 1); PG8_SCHED; PG8_LDA(At, 1, 0); PG8_STAGE(PG8_SA(0, 1), a2 + hstep, voffA);
            PG8_WAIT_V(8); PG8_WAIT_L(0); PG8_BAR; PG8_MMA(0, 0, At, B0); PG8_MMA(0, 1, At, B1); PG8_BAR; PG8_SCHED;
            PG8_LDA(At, 1, 1); PG8_STAGE(PG8_SB(1, 0), b3, voffB); PG8_STAGE(PG8_SB(1, 1), b3 + hstep, voffB); PG8_STAGE(PG8_SA(1, 0), a3, voffA);
            PG8_WAIT_V(8); PG8_WAIT_L(0); PG8_BAR; PG8_MMA(1, 0, At, B0); PG8_MMA(1, 1, At, B1); PG8_BAR; PG8_SCHED;
            } else {
            PG8_LDB(B0, 0, 0); PG8_SCHED; PG8_LDA(At, 0, 0); PG8_STAGE(PG8_SA(1, 1), a1 + hstep, voffA);
            PG8_WAIT_L(8); PG8_BAR; PG8_WAIT_L(0); PG8_MMA(0, 0, At, B0); PG8_BAR; PG8_SCHED;
            PG8_LDB(B1, 0, 1); PG8_STAGE(PG8_SB(0, 0), b2, voffB);
            PG8_BAR; PG8_WAIT_L(0); PG8_MMA(0, 1, At, B1); PG8_BAR;
            PG8_LDA(At, 0, 1); PG8_STAGE(PG8_SA(0, 0), a2, voffA);
            PG8_BAR; PG8_WAIT_L(0); PG8_MMA(1, 0, At, B0); PG8_BAR; PG8_SCHED;
            PG8_STAGE(PG8_SB(0, 1), b2 + hstep, voffB);
            PG8_WAIT_V(6); PG8_BAR; PG8_MMA(1, 1, At, B1); PG8_BAR;
            PG8_LDB(B0, 1, 0); PG8_SCHED; PG8_LDA(At, 1, 0); PG8_STAGE(PG8_SA(0, 1), a2 + hstep, voffA);
            PG8_WAIT_L(8); PG8_BAR; PG8_WAIT_L(0); PG8_MMA(0, 0, At, B0); PG8_BAR; PG8_SCHED;
            PG8_LDB(B1, 1, 1); PG8_STAGE(PG8_SB(1, 0), b3, voffB);
            PG8_BAR; PG8_WAIT_L(0); PG8_MMA(0, 1, At, B1); PG8_BAR;
            PG8_LDA(At, 1, 1); PG8_STAGE(PG8_SA(1, 0), a3, voffA);
            PG8_BAR; PG8_WAIT_L(0); PG8_MMA(1, 0, At, B0); PG8_BAR; PG8_SCHED;
            PG8_STAGE(PG8_SB(1, 1), b3 + hstep, voffB);
            PG8_WAIT_V(6); PG8_BAR; PG8_MMA(1, 1, At, B1); PG8_BAR;
            }
        }
        if constexpr (ALIGN_EPI) { if (wr == 0) PG8_BAR; }
        if constexpr (!Epi::AFTER_DRAIN) { E(acc, cur, wr, wc, fr, fq); S.done(cur); }
        if (!has_next) break;
#pragma unroll
        for (int a = 0; a < 2; ++a)
#pragma unroll
            for (int b = 0; b < 2; ++b)
#pragma unroll
                for (int m = 0; m < 4; ++m)
#pragma unroll
                    for (int n = 0; n < 2; ++n) acc[a][b][m][n] = (f32x4){0.f, 0.f, 0.f, 0.f};
        cur = nxt; cA = nA; cB = nB; ++ui;
        if constexpr (ALIGN_EPI) { if (wr == 1) PG8_BAR; }
    }
    PG8_WAIT_V(0);
    if constexpr (!ALIGN_EPI) { if (wr == 0) PG8_BAR; }
    PG8_BAR;
    if constexpr (Epi::AFTER_DRAIN) { E.fused(acc, cur, wr, wc, fr, fq, lds, wid, lane); S.done(cur); }
#undef PG8_SA
#undef PG8_SB
#undef PG8_STAGE
#undef PG8_LDA
#undef PG8_LDB
#undef PG8_MMA
#undef PG8_WAIT_V
#undef PG8_WAIT_L
#undef PG8_BAR
#undef PG8_SCHED
}
}


constexpr int BATCH = 8, SEQ = 4096, DM = 1024, MTOK = BATCH * SEQ;
constexpr int NH = 8, HD = 64;
constexpr int NPROJ = 4224, NPROJ_PAD = 4352;
constexpr int C_R = 0, C_K = 512, C_V = 1024, C_Q = 1536, C_KA = 2048, C_VA = 2560, C_G = 3072, C_WD = 4096, C_AD = 4160;
__host__ __device__ __forceinline__ int oldcol(int n) { return n < 1536 ? n : (n < 4096 ? n + 128 : n - 2560); }
constexpr float RMS_EPS = 1e-6f, GN_EPS = 64e-5f;

#define GAS __attribute__((address_space(1)))
#define LAS __attribute__((address_space(3)))
typedef unsigned short bf16;
typedef unsigned v4u __attribute__((ext_vector_type(4)));
typedef float f32x4 __attribute__((ext_vector_type(4)));
__device__ __forceinline__ unsigned f2bf(float f) { unsigned u = __builtin_bit_cast(unsigned, f); return (u + 0x7fffu + ((u >> 16) & 1u)) >> 16; }
__device__ __forceinline__ unsigned pk2(float lo, float hi) { return f2bf(lo) | (f2bf(hi) << 16); }
__device__ __forceinline__ float bf2f(bf16 v) { return __builtin_bit_cast(float, (unsigned)v << 16); }
__device__ __forceinline__ float wave_sum(float v) {
#pragma unroll
    for (int o = 1; o < 64; o <<= 1) v += __shfl_xor(v, o);
    return v;
}
__device__ __forceinline__ float wave_max(float v) {
#pragma unroll
    for (int o = 1; o < 64; o <<= 1) v = fmaxf(v, __shfl_xor(v, o));
    return v;
}
#define LDS_WAIT() asm volatile("s_waitcnt lgkmcnt(0)" ::: "memory")

constexpr size_t MiB = 1u << 20;
constexpr size_t WS_CTL = 0;
constexpr size_t WS_WIN = 2 * MiB;
constexpr size_t WS_WOUT = 11 * MiB;
constexpr size_t WS_KMEAN = 13 * MiB;
constexpr size_t WS_XN = 16 * MiB;
constexpr size_t WS_PROJ = 80 * MiB;
constexpr size_t WS_OBUF = 352 * MiB;
constexpr size_t WS_END = 480 * MiB;

__device__ __forceinline__ void p0_transpose_item(const float* W, int K, int N, bf16* WT, bool perm, LAS float* scr, int item, int lane) {
    const int nblk_new = perm ? (NPROJ / 32) : (N / 32);
    const int kb = item / nblk_new, nb = item % nblk_new, k0 = 64 * kb, n0new = 32 * nb, n0 = perm ? oldcol(n0new) : n0new;
#pragma unroll 8
    for (int i = 0; i < 32; ++i) { const int kk = 2 * i + (lane >> 5); scr[kk * 33 + (lane & 31)] = W[(size_t)(k0 + kk) * N + n0 + (lane & 31)]; }
    LDS_WAIT(); asm volatile("" ::: "memory");
    const int c = lane & 7;
#pragma unroll
    for (int j = 0; j < 4; ++j) { const int n = (lane >> 3) + 8 * j; const LAS float* s = scr + (8 * c) * 33 + n;
        v4u o; o.x = pk2(s[0 * 33], s[1 * 33]); o.y = pk2(s[2 * 33], s[3 * 33]); o.z = pk2(s[4 * 33], s[5 * 33]); o.w = pk2(s[6 * 33], s[7 * 33]);
        *(GAS v4u*)(WT + (size_t)(n0new + n) * K + k0 + 8 * c) = o; }
    LDS_WAIT(); asm volatile("" ::: "memory");
}
__device__ __forceinline__ void rms_row_to_bf16(const float* xrow, const float* g, bf16* orow, int lane) {
    const GAS f32x4* xr = (const GAS f32x4*)xrow + lane;
    const GAS f32x4* gr = (const GAS f32x4*)g + lane;
    f32x4 v[4]; float s = 0.f;
#pragma unroll
    for (int j = 0; j < 4; ++j) { v[j] = xr[64 * j]; s += (v[j].x * v[j].x + v[j].y * v[j].y) + (v[j].z * v[j].z + v[j].w * v[j].w); }
    const float rs = 1.f / sqrtf(wave_sum(s) * (1.f / DM) + RMS_EPS);
    GAS unsigned long long* o8 = (GAS unsigned long long*)orow + lane;
#pragma unroll
    for (int j = 0; j < 4; ++j) { const f32x4 gg = gr[64 * j];
        o8[64 * j] = (unsigned long long)pk2(v[j].x * rs * gg.x, v[j].y * rs * gg.y) | ((unsigned long long)pk2(v[j].z * rs * gg.z, v[j].w * rs * gg.w) << 32); }
}
struct Args { const float* in[15]; float* out; unsigned char* ws; };

__global__ void __launch_bounds__(512, 2) k_prologue(Args a) {
    extern __shared__ __attribute__((aligned(16))) unsigned char lds[];
    const int tid = threadIdx.x, lane = tid & 63, wave = tid >> 6;
    LAS float* scr = (LAS float*)((LAS unsigned char*)lds + wave * 16384);
    const int gw = blockIdx.x * 8 + wave, NGW = gridDim.x * 8;
    bf16* WinT = (bf16*)(a.ws + WS_WIN); bf16* WoutT = (bf16*)(a.ws + WS_WOUT); bf16* XN = (bf16*)(a.ws + WS_XN);
    constexpr int I_IN = (DM / 64) * (NPROJ / 32), I_OUT = (DM / 64) * (DM / 32);
    for (int it = gw; it < I_IN + I_OUT; it += NGW) {
        if (it < I_IN) p0_transpose_item(a.in[2], DM, NPROJ, WinT, true, scr, it, lane);
        else p0_transpose_item(a.in[13], DM, DM, WoutT, false, scr, it - I_IN, lane);
    }
    { v4u z = {0u, 0u, 0u, 0u}; GAS v4u* p = (GAS v4u*)(WinT + (size_t)NPROJ * DM);
      for (int i = blockIdx.x * 512 + tid; i < 128 * 1024 * 2 / 16; i += gridDim.x * 512) p[i] = z; }
    for (int m = gw; m < MTOK; m += NGW) rms_row_to_bf16(a.in[0] + (size_t)m * DM, a.in[1], XN + (size_t)m * DM, lane);
}

__global__ void __launch_bounds__(512, 2) k_gemm1(Args a) {
    extern __shared__ __attribute__((aligned(16))) unsigned char lds[];
    pg8::Gemm g{(const pg8::bf16_t*)(a.ws + WS_XN), (const pg8::bf16_t*)(a.ws + WS_WIN), MTOK, NPROJ_PAD, DM};
    pg8::StaticOrder S; S.init(MTOK, NPROJ_PAD, gridDim.x, (int)blockIdx.x);
    pg8::EpiBf16<0> E{(pg8::bf16_t*)(a.ws + WS_PROJ), NPROJ_PAD, nullptr, 0, 0, 1.f};
    pg8::gemm_phase<pg8::EpiBf16<0>, pg8::StaticOrder, true, true>((PG8_LAS unsigned char*)lds, g, S, E);
}
__global__ void __launch_bounds__(512, 2) k_gemm2(Args a) {
    extern __shared__ __attribute__((aligned(16))) unsigned char lds[];
    pg8::Gemm g{(const pg8::bf16_t*)(a.ws + WS_XN), (const pg8::bf16_t*)(a.ws + WS_WOUT), MTOK, DM, DM};
    pg8::StaticOrder S; S.init(MTOK, DM, gridDim.x, (int)blockIdx.x);
    pg8::EpiF32 E{(float*)(a.ws + WS_OBUF), DM, nullptr};
    pg8::gemm_phase<pg8::EpiF32, pg8::StaticOrder, true, true>((PG8_LAS unsigned char*)lds, g, S, E);
}
__global__ void __launch_bounds__(512) k_final(Args a) {
    const int tid = threadIdx.x, lane = tid & 63, wave = tid >> 6;
    const int gw = blockIdx.x * 8 + wave, NGW = gridDim.x * 8;
    const float* O = (const float*)(a.ws + WS_OBUF);
    for (int m = gw; m < MTOK; m += NGW) {
        const f32x4* orow = (const f32x4*)(O + (size_t)m * DM) + lane; const f32x4* xr = (const f32x4*)(a.in[0] + (size_t)m * DM) + lane; const f32x4* gr = (const f32x4*)a.in[14] + lane;
        f32x4 v[4]; float s = 0.f;
#pragma unroll
        for (int j = 0; j < 4; ++j) { v[j] = orow[64 * j]; s += (v[j].x * v[j].x + v[j].y * v[j].y) + (v[j].z * v[j].z + v[j].w * v[j].w); }
        const float rs = 1.f / sqrtf(wave_sum(s) * (1.f / DM) + RMS_EPS);
        f32x4* outr = (f32x4*)(a.out + (size_t)m * DM) + lane;
#pragma unroll
        for (int j = 0; j < 4; ++j) outr[64 * j] = xr[64 * j] + v[j] * rs * gr[64 * j];
    }
}

__global__ void __launch_bounds__(512) k_kmean(Args a) {
    const bf16* proj = (const bf16*)(a.ws + WS_PROJ); float* km = (float*)(a.ws + WS_KMEAN);
    const int b = blockIdx.x / 16, n = blockIdx.x % 16, c = threadIdx.x;
    const bf16* p = proj + ((size_t)b * SEQ + n * 256) * NPROJ_PAD + C_KA + c;
    float s = 0.f;
    for (int t = 0; t < 256; ++t) s += bf2f(p[(size_t)t * NPROJ_PAD]);
    km[(((size_t)b * NH + (c >> 6)) * 16 + n) * 64 + (c & 63)] = s * (1.f / 256.f);
}

__global__ void __launch_bounds__(256) k_moba_simple(Args a) {
    __shared__ float s_q[4][64]; __shared__ float s_g[4][16]; __shared__ float s_l[4][1024];
    const bf16* proj = (const bf16*)(a.ws + WS_PROJ); const float* km = (const float*)(a.ws + WS_KMEAN); bf16* ybuf = (bf16*)(a.ws + WS_XN);
    const int lane = threadIdx.x & 63, w = threadIdx.x >> 6;
    const int item = blockIdx.x * 4 + w;
    const int h = item & 7, m = item >> 3, b = m / SEQ, t = m % SEQ, qb = t >> 8;
    const bf16* row = proj + (size_t)m * NPROJ_PAD;
    s_q[w][lane] = bf2f(row[C_Q + h * 64 + lane]) * 0.125f;
    __syncthreads();
    float q[64];
#pragma unroll
    for (int d = 0; d < 64; ++d) q[d] = s_q[w][d];
    if (lane < 16) { float g = -1e30f; if (lane < qb) { g = 0.f; const float* kp = km + (((size_t)b * NH + h) * 16 + lane) * 64;
#pragma unroll
            for (int d = 0; d < 64; ++d) g += q[d] * kp[d]; }
        s_g[w][lane] = g; }
    __syncthreads();
    int sel[3]; { float g[16];
#pragma unroll
        for (int i = 0; i < 16; ++i) g[i] = s_g[w][i];
#pragma unroll
        for (int k = 0; k < 3; ++k) { int bi = 0; float bv = g[0];
#pragma unroll
            for (int i = 1; i < 16; ++i) if (g[i] > bv) { bv = g[i]; bi = i; }
            sel[k] = bi;
#pragma unroll
            for (int i = 0; i < 16; ++i) if (i == bi) g[i] = -3e38f; } }
    const int nv = qb < 3 ? qb : 3;
    const float slope = exp2f(-(float)(h + 1));
    const bf16* kbase = proj + (size_t)b * SEQ * NPROJ_PAD + C_KA + h * 64;
    const bf16* vbase = proj + (size_t)b * SEQ * NPROJ_PAD + C_VA + h * 64;
    float mx = -1e30f;
    for (int blk = 0; blk < 4; ++blk) {
        const bool own = (blk == 3); if (!own && blk >= nv) { for (int i = 0; i < 4; ++i) s_l[w][blk * 256 + lane + 64 * i] = -1e30f; continue; }
        const int kb = own ? qb : sel[blk];
        for (int i = 0; i < 4; ++i) { const int s = kb * 256 + lane + 64 * i; const v4u* kr = (const v4u*)(kbase + (size_t)s * NPROJ_PAD);
            float dot = 0.f;
#pragma unroll
            for (int c8 = 0; c8 < 8; ++c8) { const v4u kk = kr[c8];
                dot += q[c8 * 8 + 0] * __builtin_bit_cast(float, kk.x << 16) + q[c8 * 8 + 1] * __builtin_bit_cast(float, kk.x & 0xffff0000u)
                     + q[c8 * 8 + 2] * __builtin_bit_cast(float, kk.y << 16) + q[c8 * 8 + 3] * __builtin_bit_cast(float, kk.y & 0xffff0000u)
                     + q[c8 * 8 + 4] * __builtin_bit_cast(float, kk.z << 16) + q[c8 * 8 + 5] * __builtin_bit_cast(float, kk.z & 0xffff0000u)
                     + q[c8 * 8 + 6] * __builtin_bit_cast(float, kk.w << 16) + q[c8 * 8 + 7] * __builtin_bit_cast(float, kk.w & 0xffff0000u); }
            float lg = dot - slope * (float)(t - s);
            if (own && s > t) lg = -1e30f;
            s_l[w][blk * 256 + lane + 64 * i] = lg; mx = fmaxf(mx, lg); }
    }
    mx = wave_max(mx);
    __syncthreads();
    float sum = 0.f;
    for (int i = 0; i < 16; ++i) { const float l = s_l[w][lane + 64 * i]; const float p = (l <= -1e29f) ? 0.f : __expf(l - mx); s_l[w][lane + 64 * i] = p; sum += p; }
    sum = wave_sum(sum);
    __syncthreads();
    float o = 0.f;
    for (int blk = 0; blk < 4; ++blk) {
        const bool own = (blk == 3); if (!own && blk >= nv) continue;
        const int kb = own ? qb : sel[blk]; const int lim = own ? (t - kb * 256 + 1) : 256;
        const bf16* vp = vbase + (size_t)(kb * 256) * NPROJ_PAD + lane;
        for (int s = 0; s < lim; ++s) o += s_l[w][blk * 256 + s] * bf2f(vp[(size_t)s * NPROJ_PAD]);
    }
    const float gt = bf2f(row[C_G + 512 + h * 64 + lane]);
    const float y = (o / sum) * gt / (1.f + __expf(-gt));
    ybuf[(size_t)m * DM + 512 + h * 64 + lane] = (bf16)f2bf(y);
}

__global__ void __launch_bounds__(64) k_rwkv_seq(Args a) {
    __shared__ float s_r[16][64], s_k[16][64], s_v[16][64], s_twd[16][64], s_ad[16][64], s_dec[16][64], s_va[16][64], s_vb[16][64];
    const bf16* proj = (const bf16*)(a.ws + WS_PROJ); bf16* ybuf = (bf16*)(a.ws + WS_XN);
    const float *mu = a.in[3], *w0 = a.in[4], *w2 = a.in[5], *a0 = a.in[6], *a2 = a.in[7], *k_k = a.in[8], *k_a = a.in[9], *r_k = a.in[10], *lnw = a.in[11], *lnb = a.in[12];
    const int b = blockIdx.x >> 3, h = blockIdx.x & 7, c = threadIdx.x, hc = h * 64 + c;
    const float mu_r = mu[hc], mu_k = mu[512 + hc], mu_v = mu[1024 + hc], mu_wd = mu[1536 + c], mu_ad = mu[1600 + c];
    const float w0c = w0[hc], a0c = a0[hc], kkc = k_k[hc], kac = k_a[hc], rkc = r_k[hc], lw = lnw[hc], lb = lnb[hc];
    float w2c[64], a2c[64], S[64];
#pragma unroll
    for (int j = 0; j < 64; ++j) { w2c[j] = w2[j * 512 + hc]; a2c[j] = a2[j * 512 + hc]; S[j] = 0.f; }
    float pr = 0.f, pk = 0.f, pv = 0.f, pwd = 0.f, pad = 0.f;
    for (int tc = 0; tc < SEQ / 16; ++tc) {
        const size_t m0 = (size_t)b * SEQ + tc * 16;
#pragma unroll 4
        for (int t = 0; t < 16; ++t) { const bf16* row = proj + (m0 + t) * NPROJ_PAD;
            const float r = bf2f(row[C_R + hc]), k = bf2f(row[C_K + hc]), v = bf2f(row[C_V + hc]), wd = bf2f(row[C_WD + c]), ad = bf2f(row[C_AD + c]);
            s_r[t][c] = r + (pr - r) * mu_r; s_k[t][c] = k + (pk - k) * mu_k; s_v[t][c] = v + (pv - v) * mu_v;
            s_twd[t][c] = tanhf(wd + (pwd - wd) * mu_wd); s_ad[t][c] = ad + (pad - ad) * mu_ad;
            pr = r; pk = k; pv = v; pwd = wd; pad = ad; }
        __syncthreads();
        float bonus[16];
#pragma unroll
        for (int t = 0; t < 16; ++t) {
            float dw = 0.f, da = 0.f;
#pragma unroll
            for (int j = 0; j < 64; ++j) { dw += s_twd[t][j] * w2c[j]; da += s_ad[t][j] * a2c[j]; }
            const float xx = -(w0c + dw); const float sp = fmaxf(xx, 0.f) + log1pf(__expf(-fabsf(xx)));
            const float w = -sp - 0.5f; const float dec = __expf(-__expf(w));
            const float aa = 1.f / (1.f + __expf(-(a0c + da)));
            const float k = s_k[t][c]; float kk = k * kkc; const float n2 = wave_sum(kk * kk); kk = kk / fmaxf(sqrtf(n2), 1e-12f);
            const float kp = k * (1.f + (aa - 1.f) * kac);
            bonus[t] = wave_sum(s_r[t][c] * kp * rkc);
            s_dec[t][c] = dec; s_va[t][c] = -kk; s_vb[t][c] = kk * aa; s_k[t][c] = kp;
        }
        __syncthreads();
#pragma unroll
        for (int t = 0; t < 16; ++t) {
            const float vi = s_v[t][c]; float sa = 0.f;
#pragma unroll
            for (int j = 0; j < 64; ++j) sa += S[j] * s_va[t][j];
            float y = 0.f;
#pragma unroll
            for (int j = 0; j < 64; ++j) { S[j] = S[j] * s_dec[t][j] + sa * s_vb[t][j] + vi * s_k[t][j]; y += S[j] * s_r[t][j]; }
            const float mean = wave_sum(y) * (1.f / 64.f); const float dy = y - mean; const float var = wave_sum(dy * dy) * (1.f / 64.f);
            float yn = dy * (1.f / sqrtf(var + GN_EPS)) * lw + lb + bonus[t] * vi;
            const float gt = bf2f(proj[(m0 + t) * NPROJ_PAD + C_G + hc]);
            yn *= gt / (1.f + __expf(-gt));
            ybuf[(m0 + t) * DM + hc] = (bf16)f2bf(yn);
        }
        __syncthreads();
    }
}

extern "C" void kernel_launch(void* const* d_in, const int* in_sizes, int n_in, void* d_out, int out_size, void* d_ws, size_t ws_size, hipStream_t stream) {
    static int ok = 0;
    if (ok == 0) {
        ok = 1;
        if (n_in != 15 || in_sizes[0] != MTOK * DM || out_size != MTOK * DM || ws_size < WS_END) { fprintf(stderr, "kernel_launch: bad shapes n_in %d in0 %d out %d ws %zu\n", n_in, n_in > 0 ? in_sizes[0] : -1, out_size, ws_size); ok = -1; }
        if (hipFuncSetAttribute((const void*)k_prologue, hipFuncAttributeMaxDynamicSharedMemorySize, 131072) != hipSuccess) ok = -1;
        if (hipFuncSetAttribute((const void*)k_gemm1, hipFuncAttributeMaxDynamicSharedMemorySize, 131072) != hipSuccess) ok = -1;
        if (hipFuncSetAttribute((const void*)k_gemm2, hipFuncAttributeMaxDynamicSharedMemorySize, 131072) != hipSuccess) ok = -1;
    }
    if (ok < 0) return;
    Args a{};
    for (int i = 0; i < 15; ++i) a.in[i] = (const float*)d_in[i];
    a.out = (float*)d_out; a.ws = (unsigned char*)d_ws;
    hipLaunchKernelGGL(k_prologue, dim3(256), dim3(512), 131072, stream, a);
    hipLaunchKernelGGL(k_gemm1, dim3(256), dim3(512), 131072, stream, a);
    hipLaunchKernelGGL(k_kmean, dim3(BATCH * 16), dim3(512), 0, stream, a);
    hipLaunchKernelGGL(k_rwkv_seq, dim3(BATCH * NH), dim3(64), 0, stream, a);
    hipLaunchKernelGGL(k_moba_simple, dim3(MTOK * NH / 4), dim3(256), 0, stream, a);
    hipLaunchKernelGGL(k_gemm2, dim3(256), dim3(512), 131072, stream, a);
    hipLaunchKernelGGL(k_final, dim3(1024), dim3(512), 0, stream, a);
}
```

```cpp
#include <hip/hip_runtime.h>
#include <cstdio>
#include <cstdint>
#include <cmath>
namespace pg8 {
#define PG8_LAS __attribute__((address_space(3)))
typedef unsigned short bf16_t;
typedef short bf16x8 __attribute__((ext_vector_type(8)));
typedef float f32x4 __attribute__((ext_vector_type(4)));
typedef unsigned u32x4 __attribute__((ext_vector_type(4)));
constexpr int BM = 256, BK = 64, HALF = 128, HTB = HALF * BK * 2  , STAGE_BYTES = 8 * HTB, NXCD = 8, WGM = 8;

__host__ __device__ __forceinline__ int lds_byte(int r, int c) { const int st = (r >> 4) * 2 + (c >> 5), rr = r & 15, cc = c & 31, ob = rr * 64 + cc * 2; return st * 1024 + (ob ^ (((ob >> 9) & 1) << 5)); }
__host__ __device__ __forceinline__ void stage_rc(int b, int& R, int& C) { const int st = b / 1024, sb = b % 1024, swz = sb ^ (((sb >> 9) & 1) << 5); R = (st >> 1) * 16 + swz / 64; C = (st & 1) * 32 + (swz % 64) / 2; }
__host__ __device__ __forceinline__ int perm32(int rho) { const int n = rho >> 4, i = rho & 15; return 8 * (i >> 2) + 4 * n + (i & 3); }

struct Unit { int pm, pn; };
struct Gemm { const bf16_t* A; const bf16_t* Bt; int M, N, K; };

struct StaticOrder {
    int nM, nN, nwg, G, c;
    __host__ __device__ void init(int M, int N, int G_, int c_) { nM = M / BM; nN = N / BM; nwg = nM * nN; G = G_; c = c_; }
    __host__ __device__ bool next(int i, Unit& u) const {
        const long L = (long)i * G + c; if (L >= nwg) return false;
        int wgid = (int)L; { const int q = nwg / NXCD, r = nwg % NXCD, xcd = wgid % NXCD, off = wgid / NXCD; wgid = (xcd < r ? xcd * (q + 1) : r * (q + 1) + (xcd - r) * q) + off; }
        const int nig = WGM * nN, gid = wgid / nig, fm = gid * WGM, gsz = (nM - fm) < WGM ? (nM - fm) : WGM;
        u.pm = fm + ((wgid % nig) % gsz); u.pn = (wgid % nig) / gsz; return true;
    }
    __device__ __forceinline__ void a_ready(const Unit&) const {}
    __device__ __forceinline__ void done(const Unit&) const {}
};

__device__ __forceinline__ unsigned cvt_pk_bf16(float lo, float hi) { unsigned r; asm volatile("v_cvt_pk_bf16_f32 %0, %1, %2" : "=v"(r) : "v"(lo), "v"(hi)); return r; }
typedef float f32x2 __attribute__((ext_vector_type(2)));
__device__ __forceinline__ f32x2 gelu_pk(f32x2 v) {
    const f32x2 av = __builtin_elementwise_abs(v), d = av * 0.2316418882f + 1.0f;
    f32x2 t; t.x = __builtin_amdgcn_rcpf(d.x); t.y = __builtin_amdgcn_rcpf(d.y);
    f32x2 q = t * 0.5307027145f + (-0.7265760135f); q = q * t + 0.7107068705f; q = q * t + (-0.142248368f); q = q * t + 0.127414796f; q = q * t;
    const f32x2 s = (v * v) * (-0.72134752044f);
    f32x2 e; e.x = __builtin_amdgcn_exp2f(s.x); e.y = __builtin_amdgcn_exp2f(s.y);
    const f32x2 m = v * (q * e), r = v - m;
    f32x2 o; o.x = v.x < 0.f ? m.x : r.x; o.y = v.y < 0.f ? m.y : r.y; return o;
}

template <int ACT  > struct EpiBf16 {
    static constexpr bool PERM = true, AFTER_DRAIN = false; static_assert(ACT == 0 || ACT == 1, "EpiBf16: ACT is 0 (none) or 1 (gelu_pk)");
    bf16_t* O; int ldc; const float* bias; int split_cols; size_t split_stride; float scale0;
    __device__ __forceinline__ void operator()(const f32x4 (&acc)[2][2][4][2], const Unit& u, int wr, int wc, int fr, int fq) const {
        const int row0 = u.pm * BM + wr * 64 + fr; int colt = u.pn * BM; bf16_t* base = O;
        float sc = 1.f; if (split_cols) { const int t = colt / split_cols; base += (size_t)t * split_stride; colt -= t * split_cols; if (t == 0) sc = scale0; }
        const int col0 = colt + wc * 32 + 8 * fq, bcol0 = u.pn * BM + wc * 32 + 8 * fq;
        f32x4 bv[2][2];
#pragma unroll
        for (int bj = 0; bj < 2; ++bj)
#pragma unroll
            for (int n = 0; n < 2; ++n) bv[bj][n] = bias ? *(const f32x4*)(bias + bcol0 + bj * HALF + 4 * n) : (f32x4){0.f, 0.f, 0.f, 0.f};
#pragma unroll
        for (int ai = 0; ai < 2; ++ai)
#pragma unroll
            for (int m = 0; m < 4; ++m) { bf16_t* rowp = base + (size_t)(row0 + ai * HALF + m * 16) * ldc + col0;
#pragma unroll
                for (int bj = 0; bj < 2; ++bj) { f32x4 v0 = acc[ai][bj][m][0] + bv[bj][0], v1 = acc[ai][bj][m][1] + bv[bj][1];
                    if (ACT == 1) { f32x2 a = gelu_pk((f32x2){v0[0], v0[1]}), b = gelu_pk((f32x2){v0[2], v0[3]}), c = gelu_pk((f32x2){v1[0], v1[1]}), d = gelu_pk((f32x2){v1[2], v1[3]});
                        v0 = (f32x4){a.x, a.y, b.x, b.y}; v1 = (f32x4){c.x, c.y, d.x, d.y}; }
                    v0 = v0 * sc; v1 = v1 * sc; u32x4 w; w.x = cvt_pk_bf16(v0[0], v0[1]); w.y = cvt_pk_bf16(v0[2], v0[3]); w.z = cvt_pk_bf16(v1[0], v1[1]); w.w = cvt_pk_bf16(v1[2], v1[3]);
                    *(u32x4*)(rowp + bj * HALF) = w; } }
    }
};

struct EpiF32 {
    static constexpr bool PERM = false, AFTER_DRAIN = false;
    float* C; int ldc; const float* bias;
    __device__ __forceinline__ void operator()(const f32x4 (&acc)[2][2][4][2], const Unit& u, int wr, int wc, int fr, int fq) const {
        const int row0 = u.pm * BM + wr * 64 + fr, col0 = u.pn * BM + wc * 32 + 4 * fq;
        f32x4 bv[2][2];
#pragma unroll
        for (int bj = 0; bj < 2; ++bj)
#pragma unroll
            for (int n = 0; n < 2; ++n) bv[bj][n] = bias ? *(const f32x4*)(bias + col0 + bj * HALF + n * 16) : (f32x4){0.f, 0.f, 0.f, 0.f};
#pragma unroll
        for (int ai = 0; ai < 2; ++ai)
#pragma unroll
            for (int m = 0; m < 4; ++m) { float* rowp = C + (size_t)(row0 + ai * HALF + m * 16) * ldc + col0;
#pragma unroll
                for (int bj = 0; bj < 2; ++bj)
#pragma unroll
                    for (int n = 0; n < 2; ++n) *(f32x4*)(rowp + bj * HALF + n * 16) = acc[ai][bj][m][n] + bv[bj][n]; }
    }
};

struct PanelStats {
    unsigned* xbuf;
    unsigned* cnt;
    unsigned* tmo;
    int ntn; float eps;
    unsigned code;
    __device__ __forceinline__ bool run(const f32x4 (&v)[2][2][4][2], const Unit& u, int wr, int wc, int fr, int fq, PG8_LAS unsigned char* lds, int wid, int lane) const {
        typedef float f32x2v __attribute__((ext_vector_type(2)));
        PG8_LAS f32x2v* P = (PG8_LAS f32x2v*)lds;
        PG8_LAS f32x2v* S = (PG8_LAS f32x2v*)(lds + 8192);
        PG8_LAS unsigned* flag = (PG8_LAS unsigned*)(lds + 8192 + 2048);
#pragma unroll
        for (int ai = 0; ai < 2; ++ai)
#pragma unroll
            for (int m = 0; m < 4; ++m) {
                float s = 0.f;
#pragma unroll
                for (int bj = 0; bj < 2; ++bj)
#pragma unroll
                    for (int n = 0; n < 2; ++n) { const f32x4 x = v[ai][bj][m][n]; s += (x[0] + x[1]) + (x[2] + x[3]); }
                s += __shfl_xor(s, 16); s += __shfl_xor(s, 32);
                const float mw = s * (1.0f / 64.0f); float q = 0.f;
#pragma unroll
                for (int bj = 0; bj < 2; ++bj)
#pragma unroll
                    for (int n = 0; n < 2; ++n) { const f32x4 d = v[ai][bj][m][n] - mw; q += (d[0] * d[0] + d[1] * d[1]) + (d[2] * d[2] + d[3] * d[3]); }
                q += __shfl_xor(q, 16); q += __shfl_xor(q, 32);
                if (fq == 0) P[(ai * HALF + wr * 64 + m * 16 + fr) * 4 + wc] = (f32x2v){mw, q};
            }
        asm volatile("s_waitcnt lgkmcnt(0)" ::: "memory"); __builtin_amdgcn_s_barrier(); asm volatile("" ::: "memory");
#if defined(BROKEN_EXCHANGE_NO_WAIT)
#warning BROKEN CONTROL BUILD: the row-statistics exchange does not wait; results are wrong by design
        if (blockIdx.x >= 64) { const long long t0_ = clock64(); while (clock64() - t0_ < 60000) __builtin_amdgcn_s_sleep(8); }
#endif
        const int row = wid * 32 + (lane & 31);
        if (lane < 32) {
            const f32x2v a = P[row * 4 + 0], b = P[row * 4 + 1], c = P[row * 4 + 2], d = P[row * 4 + 3];
            const float mt = (a.x + b.x + c.x + d.x) * 0.25f;
            const float da = a.x - mt, db = b.x - mt, dc = c.x - mt, dd = d.x - mt;
            const float m2 = (a.y + b.y) + (c.y + d.y) + 64.0f * ((da * da + db * db) + (dc * dc + dd * dd));
            unsigned long long* slot = (unsigned long long*)xbuf + ((size_t)(u.pm * BM + row) * 4 + u.pn);
            __hip_atomic_store(slot, ((unsigned long long)__float_as_uint(m2) << 32) | __float_as_uint(mt), __ATOMIC_RELAXED, __HIP_MEMORY_SCOPE_AGENT);
        }
        asm volatile("s_waitcnt vmcnt(0)" ::: "memory");
        if (lane == 0) __hip_atomic_fetch_add(cnt + 64 * u.pm, 1u, __ATOMIC_RELAXED, __HIP_MEMORY_SCOPE_AGENT);
        if (wid == 0) {
            bool dead = false; const unsigned long long t0 = __builtin_amdgcn_s_memrealtime(); const unsigned want = 8u * (unsigned)ntn;
            for (;;) {
#if defined(BROKEN_EXCHANGE_NO_WAIT)
                break;
#endif
                if ((unsigned)__builtin_amdgcn_readfirstlane(__hip_atomic_load(cnt + 64 * u.pm, __ATOMIC_RELAXED, __HIP_MEMORY_SCOPE_AGENT)) >= want) break;
                if (__builtin_amdgcn_s_memrealtime() - t0 > 2000000ull) {
                    if (lane == 0) { unsigned expect = 0u; __hip_atomic_compare_exchange_strong(tmo + 1, &expect, code | (unsigned)(u.pm & 0xff), __ATOMIC_RELAXED, __ATOMIC_RELAXED, __HIP_MEMORY_SCOPE_AGENT);
                                     __hip_atomic_store(tmo, 1u, __ATOMIC_RELAXED, __HIP_MEMORY_SCOPE_AGENT); }
                    dead = true; break; }
                __builtin_amdgcn_s_sleep(2);
            }
            __builtin_amdgcn_fence(__ATOMIC_ACQUIRE, "agent");
            if (lane == 0) flag[0] = dead ? 1u : 0u;
        }
        asm volatile("s_waitcnt vmcnt(0) lgkmcnt(0)" ::: "memory"); __builtin_amdgcn_s_barrier(); asm volatile("" ::: "memory");
        const bool bad = flag[0] != 0u;
        if (lane < 32) {
            const unsigned long long* slot = (const unsigned long long*)xbuf + (size_t)(u.pm * BM + row) * 4; float mt[4], m2[4]; float ms = 0.f;
#pragma unroll
            for (int t = 0; t < 4; ++t) { if (t < ntn) { const unsigned long long w = __hip_atomic_load(slot + t, __ATOMIC_RELAXED, __HIP_MEMORY_SCOPE_AGENT); mt[t] = __uint_as_float((unsigned)w); m2[t] = __uint_as_float((unsigned)(w >> 32)); } else { mt[t] = 0.f; m2[t] = 0.f; } ms += mt[t]; }
            const float mean = ms / (float)ntn; float q = 0.f;
#pragma unroll
            for (int t = 0; t < 4; ++t) if (t < ntn) { const float dm = mt[t] - mean; q += m2[t] + 256.0f * dm * dm; }
            S[row] = (f32x2v){mean, 1.0f / sqrtf(q / (256.0f * (float)ntn) + eps)};
        }
        asm volatile("s_waitcnt lgkmcnt(0)" ::: "memory"); __builtin_amdgcn_s_barrier(); asm volatile("" ::: "memory");
        return bad;
    }
};
struct EpiLnRes {
    static constexpr bool PERM = false, AFTER_DRAIN = true;
    const float* base; float* out; int ldc; const float* bias; PanelStats st; unsigned poison;
    __device__ __forceinline__ void fused(f32x4 (&acc)[2][2][4][2], const Unit& u, int wr, int wc, int fr, int fq, PG8_LAS unsigned char* lds, int wid, int lane) const {
        typedef float f32x2v __attribute__((ext_vector_type(2)));
        const PG8_LAS f32x2v* S = (const PG8_LAS f32x2v*)(lds + 8192);
        const int col0 = u.pn * BM + wc * 32 + 4 * fq;
#pragma unroll
        for (int bj = 0; bj < 2; ++bj)
#pragma unroll
            for (int n = 0; n < 2; ++n) { const f32x4 bv = bias ? *(const f32x4*)(bias + col0 + bj * HALF + n * 16) : (f32x4){0.f, 0.f, 0.f, 0.f};
#pragma unroll
                for (int ai = 0; ai < 2; ++ai)
#pragma unroll
                    for (int m = 0; m < 4; ++m) acc[ai][bj][m][n] += bv; }
        f32x4 pre[4][2][2];
#pragma unroll
        for (int m = 0; m < 4; ++m) { const size_t off = (size_t)(u.pm * BM + wr * 64 + m * 16 + fr) * ldc + col0;
#pragma unroll
            for (int bj = 0; bj < 2; ++bj)
#pragma unroll
                for (int n = 0; n < 2; ++n) pre[m][bj][n] = *(const f32x4*)(base + off + bj * HALF + n * 16); }
        const bool bad = st.run(acc, u, wr, wc, fr, fq, lds, wid, lane) || poison != 0u;
        const float qnan = __builtin_nanf("");
#pragma unroll
        for (int ai = 0; ai < 2; ++ai)
#pragma unroll
            for (int m = 0; m < 4; ++m) { const int r = ai * HALF + wr * 64 + m * 16 + fr; const f32x2v sr = S[r]; const size_t off = (size_t)(u.pm * BM + r) * ldc + col0;
#pragma unroll
                for (int bj = 0; bj < 2; ++bj)
#pragma unroll
                    for (int n = 0; n < 2; ++n) { const f32x4 bs = ai == 0 ? pre[m][bj][n] : *(const f32x4*)(base + off + bj * HALF + n * 16); f32x4 o = bs + (acc[ai][bj][m][n] - sr.x) * sr.y;
                        if (bad) o = (f32x4){qnan, qnan, qnan, qnan}; *(f32x4*)(out + off + bj * HALF + n * 16) = o; }
                if (m & 1) asm volatile("" ::: "memory"); }
    }
};
struct EpiLnResLn {
    static constexpr bool PERM = false, AFTER_DRAIN = true;
    const float* base; float* out; bf16_t* xn; int ldc; const float* bias; PanelStats st1, st2; unsigned poison;
    __device__ __forceinline__ void fused(f32x4 (&acc)[2][2][4][2], const Unit& u, int wr, int wc, int fr, int fq, PG8_LAS unsigned char* lds, int wid, int lane) const {
        typedef float f32x2v __attribute__((ext_vector_type(2))); typedef unsigned u32x2v __attribute__((ext_vector_type(2)));
        const PG8_LAS f32x2v* S = (const PG8_LAS f32x2v*)(lds + 8192);
        const int col0 = u.pn * BM + wc * 32 + 4 * fq;
#pragma unroll
        for (int bj = 0; bj < 2; ++bj)
#pragma unroll
            for (int n = 0; n < 2; ++n) { const f32x4 bv = bias ? *(const f32x4*)(bias + col0 + bj * HALF + n * 16) : (f32x4){0.f, 0.f, 0.f, 0.f};
#pragma unroll
                for (int ai = 0; ai < 2; ++ai)
#pragma unroll
                    for (int m = 0; m < 4; ++m) acc[ai][bj][m][n] += bv; }
        bool bad = st1.run(acc, u, wr, wc, fr, fq, lds, wid, lane) || poison != 0u;
        const float qnan = __builtin_nanf("");
#pragma unroll
        for (int ai = 0; ai < 2; ++ai)
#pragma unroll
            for (int m = 0; m < 4; ++m) { const int r = ai * HALF + wr * 64 + m * 16 + fr; const f32x2v sr = S[r]; const size_t off = (size_t)(u.pm * BM + r) * ldc + col0;
#pragma unroll
                for (int bj = 0; bj < 2; ++bj)
#pragma unroll
                    for (int n = 0; n < 2; ++n) { const f32x4 bs = *(const f32x4*)(base + off + bj * HALF + n * 16); acc[ai][bj][m][n] = bs + (acc[ai][bj][m][n] - sr.x) * sr.y; }
                asm volatile("" : "+v"(acc[ai][0][m][0]), "+v"(acc[ai][0][m][1]), "+v"(acc[ai][1][m][0]), "+v"(acc[ai][1][m][1]));
                if (m & 1) asm volatile("" ::: "memory"); }
        const bool bad1 = bad;
        bad = st2.run(acc, u, wr, wc, fr, fq, lds, wid, lane) || bad;
#pragma unroll
        for (int ai = 0; ai < 2; ++ai)
#pragma unroll
            for (int m = 0; m < 4; ++m) { const int r = ai * HALF + wr * 64 + m * 16 + fr; const f32x2v sr = S[r]; const size_t off = (size_t)(u.pm * BM + r) * ldc + col0;
#pragma unroll
                for (int bj = 0; bj < 2; ++bj)
#pragma unroll
                    for (int n = 0; n < 2; ++n) { const f32x4 x1 = acc[ai][bj][m][n]; *(f32x4*)(out + off + bj * HALF + n * 16) = bad1 ? (f32x4){qnan, qnan, qnan, qnan} : x1;
                        const f32x4 o = (x1 - sr.x) * sr.y; u32x2v w; w.x = cvt_pk_bf16(o[0], o[1]); w.y = cvt_pk_bf16(o[2], o[3]);
                        if (bad) { w.x = 0x7fc07fc0u; w.y = 0x7fc07fc0u; } *(u32x2v*)(xn + off + bj * HALF + n * 16) = w; }
                asm volatile("" ::: "memory"); }
    }
};

template <class Epi, class Sched, bool ALIGN_EPI = false, bool SP2 = false>
__device__ __forceinline__ void gemm_phase(PG8_LAS unsigned char* lds, const Gemm g, const Sched& S, const Epi& E) {
    const int tid = threadIdx.x, wid = __builtin_amdgcn_readfirstlane(tid >> 6), lane = tid & 63, wr = wid >> 2, wc = wid & 3, fr = lane & 15, fq = lane >> 4;
    const int K = g.K, nt = K / BK;
    unsigned voffA[2], voffB[2];
#pragma unroll
    for (int i = 0; i < 2; ++i) { int R, C; stage_rc(tid * 16 + i * 8192, R, C); const int Rb = Epi::PERM ? ((R & ~31) + perm32(R & 31)) : R;
        voffA[i] = (unsigned)(R * K + C) * 2u; voffB[i] = (unsigned)(Rb * K + C) * 2u; }
    const size_t kstep = (size_t)(BK * 2);
    const size_t hstep = (size_t)HALF * K * 2;
    const size_t tstep = 2 * hstep;
    const unsigned ldsw = (unsigned)wid * 1024u;
    const int aoff = lds_byte(wr * 64 + fr, fq * 8), boff = lds_byte(wc * 32 + fr, fq * 8);
#define PG8_SA(b, h) (((b) * 2 + (h)) * HTB)
#define PG8_SB(b, h) ((4 + (b) * 2 + (h)) * HTB)
#define PG8_STAGE(bufoff, gbase, voff) do { _Pragma("unroll") for (int _i = 0; _i < 2; ++_i) \
        __builtin_amdgcn_global_load_lds((const unsigned*)((const char*)(gbase) + (voff)[_i]), (PG8_LAS unsigned*)(lds + (bufoff) + ldsw + _i * 8192), 16, 0, 0); } while (0)
#define PG8_LDA(dst, b, h) do { _Pragma("unroll") for (int m = 0; m < 4; ++m) _Pragma("unroll") for (int k = 0; k < 2; ++k) dst[m][k] = *(const PG8_LAS bf16x8*)(lds + PG8_SA(b, h) + aoff + m * 2048 + k * 1024); } while (0)
#define PG8_LDB(dst, b, h) do { _Pragma("unroll") for (int n = 0; n < 2; ++n) _Pragma("unroll") for (int k = 0; k < 2; ++k) dst[n][k] = *(const PG8_LAS bf16x8*)(lds + PG8_SB(b, h) + boff + n * 2048 + k * 1024); } while (0)
#define PG8_MMA(ai, bj, At, Bt) do { __builtin_amdgcn_s_setprio(1); _Pragma("unroll") for (int m = 0; m < 4; ++m) _Pragma("unroll") for (int n = 0; n < 2; ++n) _Pragma("unroll") for (int k = 0; k < 2; ++k) \
        acc[ai][bj][m][n] = __builtin_amdgcn_mfma_f32_16x16x32_bf16(Bt[n][k], At[m][k], acc[ai][bj][m][n], 0, 0, 0); __builtin_amdgcn_s_setprio(0); } while (0)
#define PG8_WAIT_V(n) asm volatile("s_waitcnt vmcnt(" #n ")" ::: "memory")
#define PG8_WAIT_L(n) asm volatile("s_waitcnt lgkmcnt(" #n ")" ::: "memory")
#define PG8_BAR __builtin_amdgcn_s_barrier()
#define PG8_SCHED __builtin_amdgcn_sched_barrier(0)
    Unit cur, nxt; int ui = 0;
    if (!S.next(0, cur)) return;
    f32x4 acc[2][2][4][2];
#pragma unroll
    for (int a = 0; a < 2; ++a)
#pragma unroll
        for (int b = 0; b < 2; ++b)
#pragma unroll
            for (int m = 0; m < 4; ++m)
#pragma unroll
                for (int n = 0; n < 2; ++n) acc[a][b][m][n] = (f32x4){0.f, 0.f, 0.f, 0.f};
    bf16x8 At[4][2], B0[2][2], B1[2][2];
    const char* cA = (const char*)g.A + (size_t)cur.pm * tstep; const char* cB = (const char*)g.Bt + (size_t)cur.pn * tstep;
    S.a_ready(cur);
    if constexpr (SP2) {
        PG8_STAGE(PG8_SB(0, 0), cB, voffB); PG8_STAGE(PG8_SB(0, 1), cB + hstep, voffB); PG8_STAGE(PG8_SA(0, 0), cA, voffA); PG8_STAGE(PG8_SA(0, 1), cA + hstep, voffA);
        if (wr == 1) PG8_BAR;
        PG8_WAIT_V(2); PG8_BAR;
        PG8_STAGE(PG8_SB(1, 0), cB + kstep, voffB); PG8_STAGE(PG8_SA(1, 0), cA + kstep, voffA); PG8_STAGE(PG8_SB(1, 1), cB + hstep + kstep, voffB);
        PG8_WAIT_V(6); PG8_BAR;
    } else {
        PG8_STAGE(PG8_SB(0, 0), cB, voffB); PG8_STAGE(PG8_SA(0, 0), cA, voffA); PG8_STAGE(PG8_SB(0, 1), cB + hstep, voffB); PG8_STAGE(PG8_SA(0, 1), cA + hstep, voffA);
        if (wr == 1) PG8_BAR;
        PG8_WAIT_V(4); PG8_BAR;
        PG8_STAGE(PG8_SB(1, 0), cB + kstep, voffB); PG8_STAGE(PG8_SA(1, 0), cA + kstep, voffA); PG8_STAGE(PG8_SB(1, 1), cB + hstep + kstep, voffB);
        PG8_WAIT_V(6); PG8_BAR;
    }
    for (;;) {
        const bool has_next = S.next(ui + 1, nxt);
        const char* nA = has_next ? (const char*)g.A + (size_t)nxt.pm * tstep : cA; const char* nB = has_next ? (const char*)g.Bt + (size_t)nxt.pn * tstep : cB;
        for (int t = 0; t < nt; t += 2) {
            const bool last = (t == nt - 2);
            const char* a1 = cA + (size_t)(t + 1) * kstep;
            const char* a2 = last ? nA : cA + (size_t)(t + 2) * kstep; const char* b2 = last ? nB : cB + (size_t)(t + 2) * kstep;
            const char* a3 = a2 + kstep; const char* b3 = b2 + kstep;
            if (last && has_next) S.a_ready(nxt);
            if constexpr (SP2) {
            PG8_LDB(B0, 0, 0); PG8_LDB(B1, 0, 1); PG8_SCHED; PG8_LDA(At, 0, 0); PG8_STAGE(PG8_SA(1, 1), a1 + hstep, voffA);
            PG8_WAIT_V(8); PG8_WAIT_L(0); PG8_BAR; PG8_MMA(0, 0, At, B0); PG8_MMA(0, 1, At, B1); PG8_BAR; PG8_SCHED;
            PG8_LDA(At, 0, 1); PG8_STAGE(PG8_SB(0, 0), b2, voffB); PG8_STAGE(PG8_SB(0, 1), b2 + hstep, voffB); PG8_STAGE(PG8_SA(0, 0), a2, voffA);
            PG8_WAIT_V(8); PG8_WAIT_L(0); PG8_BAR; PG8_MMA(1, 0, At, B0); PG8_MMA(1, 1, At, B1); PG8_BAR; PG8_SCHED;
            PG8_LDB(B0, 1, 0); PG8_LDB(B1, 1, 1); PG8_SCHED; PG8_LDA(At, 1, 0); PG8_STAGE(PG8_SA(0, 1), a2 + hstep, voffA);
            PG8_WAIT_V(8); PG8_WAIT_L(0); PG8_BAR; PG8_MMA(0, 0, At, B0); PG8_MMA(0, 1, At, B1); PG8_BAR; PG8_SCHED;
            PG8_LDA(At, 1, 1); PG8_STAGE(PG8_SB(1, 0), b3, voffB); PG8_STAGE(PG8_SB(1, 1), b3 + hstep, voffB); PG8_STAGE(PG8_SA(1, 0), a3, voffA);
            PG8_WAIT_V(8); PG8_WAIT_L(0); PG8_BAR; PG8_MMA(1, 0, At, B0); PG8_MMA(1, 1, At, B1); PG8_BAR; PG8_SCHED;
            } else {
            PG8_LDB(B0, 0, 0); PG8_SCHED; PG8_LDA(At, 0, 0); PG8_STAGE(PG8_SA(1, 1), a1 + hstep, voffA);
            PG8_WAIT_L(8); PG8_BAR; PG8_WAIT_L(0); PG8_MMA(0, 0, At, B0); PG8_BAR; PG8_SCHED;
            PG8_LDB(B1, 0, 1); PG8_STAGE(PG8_SB(0, 0), b2, voffB);
            PG8_BAR; PG8_WAIT_L(0); PG8_MMA(0, 1, At, B1); PG8_BAR;
            PG8_LDA(At, 0, 1); PG8_STAGE(PG8_SA(0, 0), a2, voffA);
            PG8_BAR; PG8_WAIT_L(0); PG8_MMA(1, 0, At, B0); PG8_BAR; PG8_SCHED;
            PG8_STAGE(PG8_SB(0, 1), b2 + hstep, voffB);
            PG8_WAIT_V(6); PG8_BAR; PG8_MMA(1, 1, At, B1); PG8_BAR;
            PG8_LDB(B0, 1, 0); PG8_SCHED; PG8_LDA(At, 1, 0); PG8_STAGE(PG8_SA(0, 1), a2 + hstep, voffA);
            PG8_WAIT_L(8); PG8_BAR; PG8_WAIT_L(0); PG8_MMA(0, 0, At, B0); PG8_BAR; PG8_SCHED;
            PG8_LDB(B1, 1, 1); PG8_STAGE(PG8_SB(1, 0), b3, voffB);
            PG8_BAR; PG8_WAIT_L(0); PG8_MMA(0, 1, At, B1); PG8_BAR;
            PG8_LDA(At, 1, 1); PG8_STAGE(PG8_SA(1, 0), a3, voffA);
            PG8_BAR; PG8_WAIT_L(0); PG8_MMA(1, 0, At, B0); PG8_BAR; PG8_SCHED;
            PG8_STAGE(PG8_SB(1, 1), b3 + hstep, voffB);
            PG8_WAIT_V(6); PG8_BAR; PG8_MMA(1, 1, At, B1); PG8_BAR;
            }
        }
        if constexpr (ALIGN_EPI) { if (wr == 0) PG8_BAR; }
        if constexpr (!Epi::AFTER_DRAIN) { E(acc, cur, wr, wc, fr, fq); S.done(cur); }
        if (!has_next) break;
#pragma unroll
        for (int a = 0; a < 2; ++a)
#pragma unroll
            for (int b = 0; b < 2; ++b)
#pragma unroll
                for (int m = 0; m < 4; ++m)
#pragma unroll
                    for (int n = 0; n < 2; ++n) acc[a][b][m][n] = (f32x4){0.f, 0.f, 0.f, 0.f};
        cur = nxt; cA = nA; cB = nB; ++ui;
        if constexpr (ALIGN_EPI) { if (wr == 1) PG8_BAR; }
    }
    PG8_WAIT_V(0);
    if constexpr (!ALIGN_EPI) { if (wr == 0) PG8_BAR; }
    PG8_BAR;
    if constexpr (Epi::AFTER_DRAIN) { E.fused(acc, cur, wr, wc, fr, fq, lds, wid, lane); S.done(cur); }
#undef PG8_SA
#undef PG8_SB
#undef PG8_STAGE
#undef PG8_LDA
#undef PG8_LDB
#undef PG8_MMA
#undef PG8_WAIT_V
#undef PG8_WAIT_L
#undef PG8_BAR
#undef PG8_SCHED
}
}


constexpr int BATCH = 8, SEQ = 4096, DM = 1024, MTOK = BATCH * SEQ;
constexpr int NH = 8, HD = 64;
constexpr int NPROJ = 4224, NPROJ_PAD = 4352;
constexpr int C_R = 0, C_K = 512, C_V = 1024, C_Q = 1536, C_KA = 2048, C_VA = 2560, C_G = 3072, C_WD = 4096, C_AD = 4160;
__host__ __device__ __forceinline__ int oldcol(int n) { return n < 1536 ? n : (n < 4096 ? n + 128 : n - 2560); }
constexpr float RMS_EPS = 1e-6f, GN_EPS = 64e-5f;

#define GAS __attribute__((address_space(1)))
#define LAS __attribute__((address_space(3)))
typedef unsigned short bf16;
typedef unsigned v4u __attribute__((ext_vector_type(4)));
typedef float f32x4 __attribute__((ext_vector_type(4)));
__device__ __forceinline__ unsigned f2bf(float f) { unsigned u = __builtin_bit_cast(unsigned, f); return (u + 0x7fffu + ((u >> 16) & 1u)) >> 16; }
__device__ __forceinline__ unsigned pk2(float lo, float hi) { return f2bf(lo) | (f2bf(hi) << 16); }
__device__ __forceinline__ float bf2f(bf16 v) { return __builtin_bit_cast(float, (unsigned)v << 16); }
__device__ __forceinline__ float wave_sum(float v) {
#pragma unroll
    for (int o = 1; o < 64; o <<= 1) v += __shfl_xor(v, o);
    return v;
}
__device__ __forceinline__ float wave_max(float v) {
#pragma unroll
    for (int o = 1; o < 64; o <<= 1) v = fmaxf(v, __shfl_xor(v, o));
    return v;
}
#define LDS_WAIT() asm volatile("s_waitcnt lgkmcnt(0)" ::: "memory")

constexpr size_t MiB = 1u << 20;
constexpr size_t WS_CTL = 0;
constexpr size_t WS_WIN = 2 * MiB;
constexpr size_t WS_WOUT = 11 * MiB;
constexpr size_t WS_KMEAN = 13 * MiB;
constexpr size_t WS_XN = 16 * MiB;
constexpr size_t WS_PROJ = 80 * MiB;
constexpr size_t WS_OBUF = 352 * MiB;
constexpr size_t WS_END = 480 * MiB;

__device__ __forceinline__ void p0_transpose_item(const float* W, int K, int N, bf16* WT, bool perm, LAS float* scr, int item, int lane) {
    const int nblk_new = perm ? (NPROJ / 32) : (N / 32);
    const int kb = item / nblk_new, nb = item % nblk_new, k0 = 64 * kb, n0new = 32 * nb, n0 = perm ? oldcol(n0new) : n0new;
#pragma unroll 8
    for (int i = 0; i < 32; ++i) { const int kk = 2 * i + (lane >> 5); scr[kk * 33 + (lane & 31)] = W[(size_t)(k0 + kk) * N + n0 + (lane & 31)]; }
    LDS_WAIT(); asm volatile("" ::: "memory");
    const int c = lane & 7;
#pragma unroll
    for (int j = 0; j < 4; ++j) { const int n = (lane >> 3) + 8 * j; const LAS float* s = scr + (8 * c) * 33 + n;
        v4u o; o.x = pk2(s[0 * 33], s[1 * 33]); o.y = pk2(s[2 * 33], s[3 * 33]); o.z = pk2(s[4 * 33], s[5 * 33]); o.w = pk2(s[6 * 33], s[7 * 33]);
        *(GAS v4u*)(WT + (size_t)(n0new + n) * K + k0 + 8 * c) = o; }
    LDS_WAIT(); asm volatile("" ::: "memory");
}
__device__ __forceinline__ void rms_row_to_bf16(const float* xrow, const float* g, bf16* orow, int lane) {
    const GAS f32x4* xr = (const GAS f32x4*)xrow + lane;
    const GAS f32x4* gr = (const GAS f32x4*)g + lane;
    f32x4 v[4]; float s = 0.f;
#pragma unroll
    for (int j = 0; j < 4; ++j) { v[j] = xr[64 * j]; s += (v[j].x * v[j].x + v[j].y * v[j].y) + (v[j].z * v[j].z + v[j].w * v[j].w); }
    const float rs = 1.f / sqrtf(wave_sum(s) * (1.f / DM) + RMS_EPS);
    GAS unsigned long long* o8 = (GAS unsigned long long*)orow + lane;
#pragma unroll
    for (int j = 0; j < 4; ++j) { const f32x4 gg = gr[64 * j];
        o8[64 * j] = (unsigned long long)pk2(v[j].x * rs * gg.x, v[j].y * rs * gg.y) | ((unsigned long long)pk2(v[j].z * rs * gg.z, v[j].w * rs * gg.w) << 32); }
}

#define XB_TMO      128
#define XB_XCNT(j)  (256  + 64 * (j))
#define XB_XSUB(j)  (1280 + 64 * (j))
#define XB_XGEN(j)  (2304 + 64 * (j))
#define XB_TOP      3328
#define XB_TOPGEN   3392
#define XCD_BAR_WORDS 3456
#define XB_SPIN_CAP (1u << 18)

__device__ __forceinline__ unsigned xb_ld(unsigned* p)              { return __hip_atomic_load(p, __ATOMIC_RELAXED, __HIP_MEMORY_SCOPE_AGENT); }
__device__ __forceinline__ unsigned xb_add(unsigned* p, unsigned v) { return __hip_atomic_fetch_add(p, v, __ATOMIC_RELAXED, __HIP_MEMORY_SCOPE_AGENT); }
__device__ __forceinline__ unsigned xb_xcc_id() { return (unsigned)__builtin_amdgcn_s_getreg((3 << 11) | 20) & 0xFu; }
#define XB_SPIN(cond, bar) do { unsigned _sp = 0; while (cond) { __builtin_amdgcn_s_sleep(1); \
    if ((++_sp & 255u) == 0u) { if (xb_ld(&(bar)[XB_TMO])) break; if (_sp > XB_SPIN_CAP) { atomicAdd(&(bar)[XB_TMO], 1u); break; } } } } while (0)

struct XcdBarrier {
    unsigned* bar; unsigned x;
    volatile LAS unsigned* st;
};

__device__ __forceinline__ XcdBarrier xcd_barrier_post(unsigned* bar, volatile LAS unsigned* st) {
    XcdBarrier b; b.bar = bar; b.x = xb_xcc_id(); b.st = st;
    if (threadIdx.x == 0) (void)xb_add(&bar[XB_XCNT(b.x)], 1u);
    return b;
}
__device__ __forceinline__ void xcd_barrier_complete(unsigned* bar, unsigned x, unsigned& nloc, unsigned& nx) {
    const unsigned G = gridDim.x * gridDim.y * gridDim.z;
    unsigned sum, cnt, mine, sp = 0u;
    for (;;) {
        sum = 0u; cnt = 0u; mine = 0u;
#pragma unroll
        for (unsigned j = 0; j < 16; ++j) { const unsigned c = xb_ld(&bar[XB_XCNT(j)]); sum += c; cnt += (c > 0u) ? 1u : 0u; mine = (j == x) ? c : mine; }
        if (sum == G) break;
        __builtin_amdgcn_s_sleep(1);
        if ((++sp & 255u) == 0u) { if (xb_ld(&bar[XB_TMO])) break; if (sp > XB_SPIN_CAP) { atomicAdd(&bar[XB_TMO], 1u); break; } }
    }
    nloc = mine > 0u ? mine : 1u; nx = cnt > 0u ? cnt : 1u;
}

__device__ __forceinline__ void xcd_barrier(const XcdBarrier& b) {
    asm volatile("s_waitcnt vmcnt(0)" ::: "memory");
    __syncthreads();
    if (threadIdx.x == 0) {
        unsigned* bar = b.bar;
        __builtin_amdgcn_s_waitcnt(0);
        unsigned nloc = b.st[0], nx = b.st[1];
        if (nloc == 0u) { xcd_barrier_complete(bar, b.x, nloc, nx); b.st[0] = nloc; b.st[1] = nx; }
        const unsigned old = xb_add(&bar[XB_XSUB(b.x)], 1u);
        const unsigned gen = old / nloc;
        if (old + 1u == (gen + 1u) * nloc) {
            __builtin_amdgcn_fence(__ATOMIC_RELEASE, "agent");
            asm volatile("s_waitcnt vmcnt(0)" ::: "memory");
            const unsigned og = xb_add(&bar[XB_TOP], 1u);
            const unsigned tg = og / nx;
            if (og + 1u == (tg + 1u) * nx) xb_add(&bar[XB_TOPGEN], 1u);
            else XB_SPIN(xb_ld(&bar[XB_TOPGEN]) == tg, bar);
            __builtin_amdgcn_fence(__ATOMIC_ACQUIRE, "agent");
            xb_add(&bar[XB_XGEN(b.x)], 1u);
            asm volatile("s_waitcnt vmcnt(0)" ::: "memory");
        } else {
            XB_SPIN(xb_ld(&bar[XB_XGEN(b.x)]) == gen, bar);
            __builtin_amdgcn_fence(__ATOMIC_ACQUIRE, "agent");
            asm volatile("s_waitcnt vmcnt(0)" ::: "memory");
        }
    }
    __syncthreads();
}


constexpr int NWAVES = 8;
constexpr int RING_OFF = 0, RING_BYTES = 131072;
constexpr int LDSCTL_OFF = RING_BYTES, MISC_OFF = LDSCTL_OFF + 320;
constexpr int LDS_BYTES = 147456;
constexpr size_t CTL_ZERO_BYTES = 1 * MiB;
constexpr int CW_BAR = 4096;
constexpr int CW_QUEUE = 64;
typedef GAS unsigned gu32;
#define RLX_AGENT __ATOMIC_RELAXED, __HIP_MEMORY_SCOPE_AGENT

struct Args { const float* in[15]; float* out; unsigned char* ws; };

__device__ __forceinline__ void phase_prologue(const Args& a, LAS unsigned char* lds, int tid, int lane, int wave) {
    LAS float* scr = (LAS float*)(lds + wave * 16384);
    const int gw = blockIdx.x * 8 + wave, NGW = gridDim.x * 8;
    bf16* WinT = (bf16*)(a.ws + WS_WIN); bf16* WoutT = (bf16*)(a.ws + WS_WOUT); bf16* XN = (bf16*)(a.ws + WS_XN);
    constexpr int I_IN = (DM / 64) * (NPROJ / 32), I_OUT = (DM / 64) * (DM / 32);
    for (int it = gw; it < I_IN + I_OUT; it += NGW) {
        if (it < I_IN) p0_transpose_item(a.in[2], DM, NPROJ, WinT, true, scr, it, lane);
        else p0_transpose_item(a.in[13], DM, DM, WoutT, false, scr, it - I_IN, lane);
    }
    { v4u z = {0u, 0u, 0u, 0u}; GAS v4u* p = (GAS v4u*)(WinT + (size_t)NPROJ * DM);
      for (int i = blockIdx.x * 512 + tid; i < 128 * 1024 * 2 / 16; i += gridDim.x * 512) p[i] = z; }
    for (int m = gw; m < MTOK; m += NGW) rms_row_to_bf16(a.in[0] + (size_t)m * DM, a.in[1], XN + (size_t)m * DM, lane);
}

__device__ __forceinline__ void phase_final(const Args& a, int lane, int wave) {
    const int gw = blockIdx.x * 8 + wave, NGW = gridDim.x * 8;
    const float* O = (const float*)(a.ws + WS_OBUF);
    for (int m = gw; m < MTOK; m += NGW) {
        const f32x4* orow = (const f32x4*)(O + (size_t)m * DM) + lane; const f32x4* xr = (const f32x4*)(a.in[0] + (size_t)m * DM) + lane; const f32x4* gr = (const f32x4*)a.in[14] + lane;
        f32x4 v[4]; float s = 0.f;
#pragma unroll
        for (int j = 0; j < 4; ++j) { v[j] = orow[64 * j]; s += (v[j].x * v[j].x + v[j].y * v[j].y) + (v[j].z * v[j].z + v[j].w * v[j].w); }
        const float rs = 1.f / sqrtf(wave_sum(s) * (1.f / DM) + RMS_EPS);
        f32x4* outr = (f32x4*)(a.out + (size_t)m * DM) + lane;
#pragma unroll
        for (int j = 0; j < 4; ++j) outr[64 * j] = xr[64 * j] + v[j] * rs * gr[64 * j];
    }
}

__device__ __forceinline__ void phase_kmean(const Args& a, int tid) {
    const bf16* proj = (const bf16*)(a.ws + WS_PROJ); float* km = (float*)(a.ws + WS_KMEAN);
    for (int u = blockIdx.x; u < BATCH * 16; u += gridDim.x) {
        const int b = u / 16, n = u % 16, c = tid;
        const bf16* p = proj + ((size_t)b * SEQ + n * 256) * NPROJ_PAD + C_KA + c;
        float s = 0.f;
        for (int t = 0; t < 256; ++t) s += bf2f(p[(size_t)t * NPROJ_PAD]);
        km[(((size_t)b * NH + (c >> 6)) * 16 + n) * 64 + (c & 63)] = s * (1.f / 256.f);
    }
}

#define WAVE_LDS_SYNC() do { asm volatile("s_waitcnt lgkmcnt(0)" ::: "memory"); } while (0)

__device__ __forceinline__ void moba_simple_item(const Args& a, int item, LAS float* scr, int lane) {
    LAS float* s_q = scr; LAS float* s_g = scr + 64; LAS float* s_l = scr + 128;
    const bf16* proj = (const bf16*)(a.ws + WS_PROJ); const float* km = (const float*)(a.ws + WS_KMEAN); bf16* ybuf = (bf16*)(a.ws + WS_XN);
    const int h = item & 7, m = item >> 3, b = m / SEQ, t = m % SEQ, qb = t >> 8;
    const bf16* row = proj + (size_t)m * NPROJ_PAD;
    s_q[lane] = bf2f(row[C_Q + h * 64 + lane]) * 0.125f;
    WAVE_LDS_SYNC();
    float q[64];
#pragma unroll
    for (int d = 0; d < 64; ++d) q[d] = s_q[d];
    if (lane < 16) { float g = -1e30f; if (lane < qb) { g = 0.f; const float* kp = km + (((size_t)b * NH + h) * 16 + lane) * 64;
#pragma unroll
            for (int d = 0; d < 64; ++d) g += q[d] * kp[d]; }
        s_g[lane] = g; }
    WAVE_LDS_SYNC();
    int sel0, sel1, sel2; { float g[16]; int sl[3];
#pragma unroll
        for (int i = 0; i < 16; ++i) g[i] = s_g[i];
#pragma unroll
        for (int k = 0; k < 3; ++k) { int bi = 0; float bv = g[0];
#pragma unroll
            for (int i = 1; i < 16; ++i) if (g[i] > bv) { bv = g[i]; bi = i; }
            sl[k] = bi;
#pragma unroll
            for (int i = 0; i < 16; ++i) if (i == bi) g[i] = -3e38f; }
        sel0 = sl[0]; sel1 = sl[1]; sel2 = sl[2]; }
    const int nv = qb < 3 ? qb : 3;
    const float slope = exp2f(-(float)(h + 1));
    const bf16* kbase = proj + (size_t)b * SEQ * NPROJ_PAD + C_KA + h * 64;
    const bf16* vbase = proj + (size_t)b * SEQ * NPROJ_PAD + C_VA + h * 64;
    float mx = -1e30f;
    for (int blk = 0; blk < 4; ++blk) {
        const bool own = (blk == 3); if (!own && blk >= nv) { for (int i = 0; i < 4; ++i) s_l[blk * 256 + lane + 64 * i] = -1e30f; continue; }
        const int kb = own ? qb : (blk == 0 ? sel0 : (blk == 1 ? sel1 : sel2));
        for (int i = 0; i < 4; ++i) { const int s = kb * 256 + lane + 64 * i; const v4u* kr = (const v4u*)(kbase + (size_t)s * NPROJ_PAD);
            float dot = 0.f;
#pragma unroll
            for (int c8 = 0; c8 < 8; ++c8) { const v4u kk = kr[c8];
                dot += q[c8 * 8 + 0] * __builtin_bit_cast(float, kk.x << 16) + q[c8 * 8 + 1] * __builtin_bit_cast(float, kk.x & 0xffff0000u)
                     + q[c8 * 8 + 2] * __builtin_bit_cast(float, kk.y << 16) + q[c8 * 8 + 3] * __builtin_bit_cast(float, kk.y & 0xffff0000u)
                     + q[c8 * 8 + 4] * __builtin_bit_cast(float, kk.z << 16) + q[c8 * 8 + 5] * __builtin_bit_cast(float, kk.z & 0xffff0000u)
                     + q[c8 * 8 + 6] * __builtin_bit_cast(float, kk.w << 16) + q[c8 * 8 + 7] * __builtin_bit_cast(float, kk.w & 0xffff0000u); }
            float lg = dot - slope * (float)(t - s);
            if (own && s > t) lg = -1e30f;
            s_l[blk * 256 + lane + 64 * i] = lg; mx = fmaxf(mx, lg); }
    }
    mx = wave_max(mx);
    WAVE_LDS_SYNC();
    float sum = 0.f;
    for (int i = 0; i < 16; ++i) { const float l = s_l[lane + 64 * i]; const float p = (l <= -1e29f) ? 0.f : __expf(l - mx); s_l[lane + 64 * i] = p; sum += p; }
    sum = wave_sum(sum);
    WAVE_LDS_SYNC();
    float o = 0.f;
    for (int blk = 0; blk < 4; ++blk) {
        const bool own = (blk == 3); if (!own && blk >= nv) continue;
        const int kb = own ? qb : (blk == 0 ? sel0 : (blk == 1 ? sel1 : sel2)); const int lim = own ? (t - kb * 256 + 1) : 256;
        const bf16* vp = vbase + (size_t)(kb * 256) * NPROJ_PAD + lane;
        for (int s = 0; s < lim; ++s) o += s_l[blk * 256 + s] * bf2f(vp[(size_t)s * NPROJ_PAD]);
    }
    const float gt = bf2f(row[C_G + 512 + h * 64 + lane]);
    const float y = (o / sum) * gt / (1.f + __expf(-gt));
    ybuf[(size_t)m * DM + 512 + h * 64 + lane] = (bf16)f2bf(y);
    WAVE_LDS_SYNC();
}

__device__ __forceinline__ void rwkv_seq_unit(const Args& a, int unit, LAS float* sm, int c) {
    LAS float* s_r = sm; LAS float* s_k = sm + 1024; LAS float* s_v = sm + 2048; LAS float* s_twd = sm + 3072; LAS float* s_ad = sm + 4096;
    LAS float* s_dec = sm + 5120; LAS float* s_va = sm + 6144; LAS float* s_vb = sm + 7168; LAS float* s_w2 = sm + 8192; LAS float* s_a2 = sm + 8192 + 4096;
    const bf16* proj = (const bf16*)(a.ws + WS_PROJ); bf16* ybuf = (bf16*)(a.ws + WS_XN);
    const float *mu = a.in[3], *w0 = a.in[4], *w2 = a.in[5], *a0 = a.in[6], *a2 = a.in[7], *k_k = a.in[8], *k_a = a.in[9], *r_k = a.in[10], *lnw = a.in[11], *lnb = a.in[12];
    const int b = unit >> 3, h = unit & 7, hc = h * 64 + c;
    const float mu_r = mu[hc], mu_k = mu[512 + hc], mu_v = mu[1024 + hc], mu_wd = mu[1536 + c], mu_ad = mu[1600 + c];
    const float w0c = w0[hc], a0c = a0[hc], kkc = k_k[hc], kac = k_a[hc], rkc = r_k[hc], lw = lnw[hc], lb = lnb[hc];
    float S[64];
#pragma unroll
    for (int j = 0; j < 64; ++j) { s_w2[j * 64 + c] = w2[j * 512 + hc]; s_a2[j * 64 + c] = a2[j * 512 + hc]; S[j] = 0.f; }
    float pr = 0.f, pk = 0.f, pv = 0.f, pwd = 0.f, pad = 0.f;
    for (int tc = 0; tc < SEQ / 16; ++tc) {
        const size_t m0 = (size_t)b * SEQ + tc * 16;
#pragma unroll 4
        for (int t = 0; t < 16; ++t) { const bf16* row = proj + (m0 + t) * NPROJ_PAD;
            const float r = bf2f(row[C_R + hc]), k = bf2f(row[C_K + hc]), v = bf2f(row[C_V + hc]), wd = bf2f(row[C_WD + c]), ad = bf2f(row[C_AD + c]);
            s_r[t * 64 + c] = r + (pr - r) * mu_r; s_k[t * 64 + c] = k + (pk - k) * mu_k; s_v[t * 64 + c] = v + (pv - v) * mu_v;
            s_twd[t * 64 + c] = tanhf(wd + (pwd - wd) * mu_wd); s_ad[t * 64 + c] = ad + (pad - ad) * mu_ad;
            pr = r; pk = k; pv = v; pwd = wd; pad = ad; }
        WAVE_LDS_SYNC();
        for (int t = 0; t < 16; ++t) {
            float dw = 0.f, da = 0.f;
#pragma unroll
            for (int j = 0; j < 64; ++j) { dw += s_twd[t * 64 + j] * s_w2[j * 64 + c]; da += s_ad[t * 64 + j] * s_a2[j * 64 + c]; }
            const float xx = -(w0c + dw); const float sp = fmaxf(xx, 0.f) + log1pf(__expf(-fabsf(xx)));
            const float w = -sp - 0.5f; const float dec = __expf(-__expf(w));
            const float aa = 1.f / (1.f + __expf(-(a0c + da)));
            const float k = s_k[t * 64 + c]; float kk = k * kkc; const float n2 = wave_sum(kk * kk); kk = kk / fmaxf(sqrtf(n2), 1e-12f);
            const float kp = k * (1.f + (aa - 1.f) * kac);
            const float bonus = wave_sum(s_r[t * 64 + c] * kp * rkc);
            s_dec[t * 64 + c] = dec; s_va[t * 64 + c] = -kk; s_vb[t * 64 + c] = kk * aa; s_k[t * 64 + c] = kp; s_twd[t * 64 + c] = bonus;
            WAVE_LDS_SYNC();
        }
        WAVE_LDS_SYNC();
        for (int t = 0; t < 16; ++t) {
            const float vi = s_v[t * 64 + c]; float sa = 0.f;
#pragma unroll
            for (int j = 0; j < 64; ++j) sa += S[j] * s_va[t * 64 + j];
            float y = 0.f;
#pragma unroll
            for (int j = 0; j < 64; ++j) { S[j] = S[j] * s_dec[t * 64 + j] + sa * s_vb[t * 64 + j] + vi * s_k[t * 64 + j]; y += S[j] * s_r[t * 64 + j]; }
            const float mean = wave_sum(y) * (1.f / 64.f); const float dy = y - mean; const float var = wave_sum(dy * dy) * (1.f / 64.f);
            float yn = dy * (1.f / sqrtf(var + GN_EPS)) * lw + lb + s_twd[t * 64 + c] * vi;
            const float gt = bf2f(proj[(m0 + t) * NPROJ_PAD + C_G + hc]);
            yn *= gt / (1.f + __expf(-gt));
            ybuf[(m0 + t) * DM + hc] = (bf16)f2bf(yn);
        }
        WAVE_LDS_SYNC();
    }
}

__global__ void __launch_bounds__(NWAVES * 64, 2) k_fused(Args a) {
    extern __shared__ __attribute__((aligned(16))) unsigned char lds_raw[];
    LAS unsigned char* lds = (LAS unsigned char*)lds_raw;
    volatile LAS unsigned* MISC = (volatile LAS unsigned*)(lds + MISC_OFF);
    const int tid = threadIdx.x, lane = tid & 63, wave = __builtin_amdgcn_readfirstlane(tid >> 6);
    gu32* ctl = (gu32*)(a.ws + WS_CTL);
    for (int u = tid; u < (LDS_BYTES - LDSCTL_OFF) / 4; u += NWAVES * 64) ((LAS unsigned*)(lds + LDSCTL_OFF))[u] = 0u;
    __syncthreads();
    XcdBarrier bar = xcd_barrier_post((unsigned*)(ctl + CW_BAR), MISC + 8);

    phase_prologue(a, lds, tid, lane, wave);
    xcd_barrier(bar);
    {
        pg8::Gemm g{(const pg8::bf16_t*)(a.ws + WS_XN), (const pg8::bf16_t*)(a.ws + WS_WIN), MTOK, NPROJ_PAD, DM};
        pg8::StaticOrder S; S.init(MTOK, NPROJ_PAD, gridDim.x, (int)blockIdx.x);
        pg8::EpiBf16<0> E{(pg8::bf16_t*)(a.ws + WS_PROJ), NPROJ_PAD, nullptr, 0, 0, 1.f};
        pg8::gemm_phase<pg8::EpiBf16<0>, pg8::StaticOrder, true, true>(lds + RING_OFF, g, S, E);
    }
    xcd_barrier(bar);
    phase_kmean(a, tid);
    xcd_barrier(bar);
    {
        if (blockIdx.x < BATCH * NH && wave == 0) rwkv_seq_unit(a, blockIdx.x, (LAS float*)(lds + RING_OFF), lane);
        LAS float* scr = (LAS float*)(lds + RING_OFF + 65536 + wave * 8192);
        constexpr int NITEMS = MTOK * NH, CH = 32;
        for (;;) {
            unsigned base = 0;
            if (lane == 0) base = __hip_atomic_fetch_add((unsigned*)(ctl + CW_QUEUE), (unsigned)CH, __ATOMIC_RELAXED, __HIP_MEMORY_SCOPE_AGENT);
            base = (unsigned)__builtin_amdgcn_readfirstlane((int)base);
            if (base >= (unsigned)NITEMS) break;
            for (int i = 0; i < CH; ++i) moba_simple_item(a, (int)base + i, scr, lane);
        }
    }
    xcd_barrier(bar);
    {
        pg8::Gemm g{(const pg8::bf16_t*)(a.ws + WS_XN), (const pg8::bf16_t*)(a.ws + WS_WOUT), MTOK, DM, DM};
        pg8::StaticOrder S; S.init(MTOK, DM, gridDim.x, (int)blockIdx.x);
        pg8::EpiF32 E{(float*)(a.ws + WS_OBUF), DM, nullptr};
        pg8::gemm_phase<pg8::EpiF32, pg8::StaticOrder, true, true>(lds + RING_OFF, g, S, E);
    }
    xcd_barrier(bar);
    phase_final(a, lane, wave);
}

extern "C" void kernel_launch(void* const* d_in, const int* in_sizes, int n_in, void* d_out, int out_size, void* d_ws, size_t ws_size, hipStream_t stream) {
    static int grid = 0;
    if (grid == 0) {
        if (n_in != 15 || in_sizes[0] != MTOK * DM || out_size != MTOK * DM || ws_size < WS_END) { fprintf(stderr, "kernel_launch: bad shapes n_in %d in0 %d out %d ws %zu\n", n_in, n_in > 0 ? in_sizes[0] : -1, out_size, ws_size); grid = -1; return; }
        int dev = 0, cus = 0, per_cu = 0;
        if (hipGetDevice(&dev) != hipSuccess || hipDeviceGetAttribute(&cus, hipDeviceAttributeMultiprocessorCount, dev) != hipSuccess) { grid = -1; return; }
        if (hipFuncSetAttribute((const void*)k_fused, hipFuncAttributeMaxDynamicSharedMemorySize, LDS_BYTES) != hipSuccess) { grid = -1; return; }
        if (hipOccupancyMaxActiveBlocksPerMultiprocessor(&per_cu, (const void*)k_fused, NWAVES * 64, LDS_BYTES) != hipSuccess || per_cu < 1) { fprintf(stderr, "kernel_launch: occupancy query says %d\n", per_cu); }
        (void)hipGetLastError();
        grid = cus;
    }
    if (grid < 0) return;
    if (hipMemsetAsync((char*)d_ws + WS_CTL, 0, CTL_ZERO_BYTES, stream) != hipSuccess) return;
    Args a{};
    for (int i = 0; i < 15; ++i) a.in[i] = (const float*)d_in[i];
    a.out = (float*)d_out; a.ws = (unsigned char*)d_ws;
    hipLaunchKernelGGL(k_fused, dim3(grid), dim3(NWAVES * 64), LDS_BYTES, stream, a);
}
```

```cpp
#include <hip/hip_runtime.h>
#include <cstdio>
#include <cstdint>
#include <cmath>
namespace pg8 {
#define PG8_LAS __attribute__((address_space(3)))
typedef unsigned short bf16_t;
typedef short bf16x8 __attribute__((ext_vector_type(8)));
typedef float f32x4 __attribute__((ext_vector_type(4)));
typedef unsigned u32x4 __attribute__((ext_vector_type(4)));
constexpr int BM = 256, BK = 64, HALF = 128, HTB = HALF * BK * 2  , STAGE_BYTES = 8 * HTB, NXCD = 8, WGM = 8;

__host__ __device__ __forceinline__ int lds_byte(int r, int c) { const int st = (r >> 4) * 2 + (c >> 5), rr = r & 15, cc = c & 31, ob = rr * 64 + cc * 2; return st * 1024 + (ob ^ (((ob >> 9) & 1) << 5)); }
__host__ __device__ __forceinline__ void stage_rc(int b, int& R, int& C) { const int st = b / 1024, sb = b % 1024, swz = sb ^ (((sb >> 9) & 1) << 5); R = (st >> 1) * 16 + swz / 64; C = (st & 1) * 32 + (swz % 64) / 2; }
__host__ __device__ __forceinline__ int perm32(int rho) { const int n = rho >> 4, i = rho & 15; return 8 * (i >> 2) + 4 * n + (i & 3); }

struct Unit { int pm, pn; };
struct Gemm { const bf16_t* A; const bf16_t* Bt; int M, N, K; };

struct StaticOrder {
    int nM, nN, nwg, G, c;
    __host__ __device__ void init(int M, int N, int G_, int c_) { nM = M / BM; nN = N / BM; nwg = nM * nN; G = G_; c = c_; }
    __host__ __device__ bool next(int i, Unit& u) const {
        const long L = (long)i * G + c; if (L >= nwg) return false;
        int wgid = (int)L; { const int q = nwg / NXCD, r = nwg % NXCD, xcd = wgid % NXCD, off = wgid / NXCD; wgid = (xcd < r ? xcd * (q + 1) : r * (q + 1) + (xcd - r) * q) + off; }
        const int nig = WGM * nN, gid = wgid / nig, fm = gid * WGM, gsz = (nM - fm) < WGM ? (nM - fm) : WGM;
        u.pm = fm + ((wgid % nig) % gsz); u.pn = (wgid % nig) / gsz; return true;
    }
    __device__ __forceinline__ void a_ready(const Unit&) const {}
    __device__ __forceinline__ void done(const Unit&) const {}
};

__device__ __forceinline__ unsigned cvt_pk_bf16(float lo, float hi) { unsigned r; asm volatile("v_cvt_pk_bf16_f32 %0, %1, %2" : "=v"(r) : "v"(lo), "v"(hi)); return r; }
typedef float f32x2 __attribute__((ext_vector_type(2)));
__device__ __forceinline__ f32x2 gelu_pk(f32x2 v) {
    const f32x2 av = __builtin_elementwise_abs(v), d = av * 0.2316418882f + 1.0f;
    f32x2 t; t.x = __builtin_amdgcn_rcpf(d.x); t.y = __builtin_amdgcn_rcpf(d.y);
    f32x2 q = t * 0.5307027145f + (-0.7265760135f); q = q * t + 0.7107068705f; q = q * t + (-0.142248368f); q = q * t + 0.127414796f; q = q * t;
    const f32x2 s = (v * v) * (-0.72134752044f);
    f32x2 e; e.x = __builtin_amdgcn_exp2f(s.x); e.y = __builtin_amdgcn_exp2f(s.y);
    const f32x2 m = v * (q * e), r = v - m;
    f32x2 o; o.x = v.x < 0.f ? m.x : r.x; o.y = v.y < 0.f ? m.y : r.y; return o;
}

template <int ACT  > struct EpiBf16 {
    static constexpr bool PERM = true, AFTER_DRAIN = false; static_assert(ACT == 0 || ACT == 1, "EpiBf16: ACT is 0 (none) or 1 (gelu_pk)");
    bf16_t* O; int ldc; const float* bias; int split_cols; size_t split_stride; float scale0;
    __device__ __forceinline__ void operator()(const f32x4 (&acc)[2][2][4][2], const Unit& u, int wr, int wc, int fr, int fq) const {
        const int row0 = u.pm * BM + wr * 64 + fr; int colt = u.pn * BM; bf16_t* base = O;
        float sc = 1.f; if (split_cols) { const int t = colt / split_cols; base += (size_t)t * split_stride; colt -= t * split_cols; if (t == 0) sc = scale0; }
        const int col0 = colt + wc * 32 + 8 * fq, bcol0 = u.pn * BM + wc * 32 + 8 * fq;
        f32x4 bv[2][2];
#pragma unroll
        for (int bj = 0; bj < 2; ++bj)
#pragma unroll
            for (int n = 0; n < 2; ++n) bv[bj][n] = bias ? *(const f32x4*)(bias + bcol0 + bj * HALF + 4 * n) : (f32x4){0.f, 0.f, 0.f, 0.f};
#pragma unroll
        for (int ai = 0; ai < 2; ++ai)
#pragma unroll
            for (int m = 0; m < 4; ++m) { bf16_t* rowp = base + (size_t)(row0 + ai * HALF + m * 16) * ldc + col0;
#pragma unroll
                for (int bj = 0; bj < 2; ++bj) { f32x4 v0 = acc[ai][bj][m][0] + bv[bj][0], v1 = acc[ai][bj][m][1] + bv[bj][1];
                    if (ACT == 1) { f32x2 a = gelu_pk((f32x2){v0[0], v0[1]}), b = gelu_pk((f32x2){v0[2], v0[3]}), c = gelu_pk((f32x2){v1[0], v1[1]}), d = gelu_pk((f32x2){v1[2], v1[3]});
                        v0 = (f32x4){a.x, a.y, b.x, b.y}; v1 = (f32x4){c.x, c.y, d.x, d.y}; }
                    v0 = v0 * sc; v1 = v1 * sc; u32x4 w; w.x = cvt_pk_bf16(v0[0], v0[1]); w.y = cvt_pk_bf16(v0[2], v0[3]); w.z = cvt_pk_bf16(v1[0], v1[1]); w.w = cvt_pk_bf16(v1[2], v1[3]);
                    *(u32x4*)(rowp + bj * HALF) = w; } }
    }
};

struct EpiF32 {
    static constexpr bool PERM = false, AFTER_DRAIN = false;
    float* C; int ldc; const float* bias;
    __device__ __forceinline__ void operator()(const f32x4 (&acc)[2][2][4][2], const Unit& u, int wr, int wc, int fr, int fq) const {
        const int row0 = u.pm * BM + wr * 64 + fr, col0 = u.pn * BM + wc * 32 + 4 * fq;
        f32x4 bv[2][2];
#pragma unroll
        for (int bj = 0; bj < 2; ++bj)
#pragma unroll
            for (int n = 0; n < 2; ++n) bv[bj][n] = bias ? *(const f32x4*)(bias + col0 + bj * HALF + n * 16) : (f32x4){0.f, 0.f, 0.f, 0.f};
#pragma unroll
        for (int ai = 0; ai < 2; ++ai)
#pragma unroll
            for (int m = 0; m < 4; ++m) { float* rowp = C + (size_t)(row0 + ai * HALF + m * 16) * ldc + col0;
#pragma unroll
                for (int bj = 0; bj < 2; ++bj)
#pragma unroll
                    for (int n = 0; n < 2; ++n) *(f32x4*)(rowp + bj * HALF + n * 16) = acc[ai][bj][m][n] + bv[bj][n]; }
    }
};

struct PanelStats {
    unsigned* xbuf;
    unsigned* cnt;
    unsigned* tmo;
    int ntn; float eps;
    unsigned code;
    __device__ __forceinline__ bool run(const f32x4 (&v)[2][2][4][2], const Unit& u, int wr, int wc, int fr, int fq, PG8_LAS unsigned char* lds, int wid, int lane) const {
        typedef float f32x2v __attribute__((ext_vector_type(2)));
        PG8_LAS f32x2v* P = (PG8_LAS f32x2v*)lds;
        PG8_LAS f32x2v* S = (PG8_LAS f32x2v*)(lds + 8192);
        PG8_LAS unsigned* flag = (PG8_LAS unsigned*)(lds + 8192 + 2048);
#pragma unroll
        for (int ai = 0; ai < 2; ++ai)
#pragma unroll
            for (int m = 0; m < 4; ++m) {
                float s = 0.f;
#pragma unroll
                for (int bj = 0; bj < 2; ++bj)
#pragma unroll
                    for (int n = 0; n < 2; ++n) { const f32x4 x = v[ai][bj][m][n]; s += (x[0] + x[1]) + (x[2] + x[3]); }
                s += __shfl_xor(s, 16); s += __shfl_xor(s, 32);
                const float mw = s * (1.0f / 64.0f); float q = 0.f;
#pragma unroll
                for (int bj = 0; bj < 2; ++bj)
#pragma unroll
                    for (int n = 0; n < 2; ++n) { const f32x4 d = v[ai][bj][m][n] - mw; q += (d[0] * d[0] + d[1] * d[1]) + (d[2] * d[2] + d[3] * d[3]); }
                q += __shfl_xor(q, 16); q += __shfl_xor(q, 32);
                if (fq == 0) P[(ai * HALF + wr * 64 + m * 16 + fr) * 4 + wc] = (f32x2v){mw, q};
            }
        asm volatile("s_waitcnt lgkmcnt(0)" ::: "memory"); __builtin_amdgcn_s_barrier(); asm volatile("" ::: "memory");
#if defined(BROKEN_EXCHANGE_NO_WAIT)
#warning BROKEN CONTROL BUILD: the row-statistics exchange does not wait; results are wrong by design
        if (blockIdx.x >= 64) { const long long t0_ = clock64(); while (clock64() - t0_ < 60000) __builtin_amdgcn_s_sleep(8); }
#endif
        const int row = wid * 32 + (lane & 31);
        if (lane < 32) {
            const f32x2v a = P[row * 4 + 0], b = P[row * 4 + 1], c = P[row * 4 + 2], d = P[row * 4 + 3];
            const float mt = (a.x + b.x + c.x + d.x) * 0.25f;
            const float da = a.x - mt, db = b.x - mt, dc = c.x - mt, dd = d.x - mt;
            const float m2 = (a.y + b.y) + (c.y + d.y) + 64.0f * ((da * da + db * db) + (dc * dc + dd * dd));
            unsigned long long* slot = (unsigned long long*)xbuf + ((size_t)(u.pm * BM + row) * 4 + u.pn);
            __hip_atomic_store(slot, ((unsigned long long)__float_as_uint(m2) << 32) | __float_as_uint(mt), __ATOMIC_RELAXED, __HIP_MEMORY_SCOPE_AGENT);
        }
        asm volatile("s_waitcnt vmcnt(0)" ::: "memory");
        if (lane == 0) __hip_atomic_fetch_add(cnt + 64 * u.pm, 1u, __ATOMIC_RELAXED, __HIP_MEMORY_SCOPE_AGENT);
        if (wid == 0) {
            bool dead = false; const unsigned long long t0 = __builtin_amdgcn_s_memrealtime(); const unsigned want = 8u * (unsigned)ntn;
            for (;;) {
#if defined(BROKEN_EXCHANGE_NO_WAIT)
                break;
#endif
                if ((unsigned)__builtin_amdgcn_readfirstlane(__hip_atomic_load(cnt + 64 * u.pm, __ATOMIC_RELAXED, __HIP_MEMORY_SCOPE_AGENT)) >= want) break;
                if (__builtin_amdgcn_s_memrealtime() - t0 > 2000000ull) {
                    if (lane == 0) { unsigned expect = 0u; __hip_atomic_compare_exchange_strong(tmo + 1, &expect, code | (unsigned)(u.pm & 0xff), __ATOMIC_RELAXED, __ATOMIC_RELAXED, __HIP_MEMORY_SCOPE_AGENT);
                                     __hip_atomic_store(tmo, 1u, __ATOMIC_RELAXED, __HIP_MEMORY_SCOPE_AGENT); }
                    dead = true; break; }
                __builtin_amdgcn_s_sleep(2);
            }
            __builtin_amdgcn_fence(__ATOMIC_ACQUIRE, "agent");
            if (lane == 0) flag[0] = dead ? 1u : 0u;
        }
        asm volatile("s_waitcnt vmcnt(0) lgkmcnt(0)" ::: "memory"); __builtin_amdgcn_s_barrier(); asm volatile("" ::: "memory");
        const bool bad = flag[0] != 0u;
        if (lane < 32) {
            const unsigned long long* slot = (const unsigned long long*)xbuf + (size_t)(u.pm * BM + row) * 4; float mt[4], m2[4]; float ms = 0.f;
#pragma unroll
            for (int t = 0; t < 4; ++t) { if (t < ntn) { const unsigned long long w = __hip_atomic_load(slot + t, __ATOMIC_RELAXED, __HIP_MEMORY_SCOPE_AGENT); mt[t] = __uint_as_float((unsigned)w); m2[t] = __uint_as_float((unsigned)(w >> 32)); } else { mt[t] = 0.f; m2[t] = 0.f; } ms += mt[t]; }
            const float mean = ms / (float)ntn; float q = 0.f;
#pragma unroll
            for (int t = 0; t < 4; ++t) if (t < ntn) { const float dm = mt[t] - mean; q += m2[t] + 256.0f * dm * dm; }
            S[row] = (f32x2v){mean, 1.0f / sqrtf(q / (256.0f * (float)ntn) + eps)};
        }
        asm volatile("s_waitcnt lgkmcnt(0)" ::: "memory"); __builtin_amdgcn_s_barrier(); asm volatile("" ::: "memory");
        return bad;
    }
};
struct EpiLnRes {
    static constexpr bool PERM = false, AFTER_DRAIN = true;
    const float* base; float* out; int ldc; const float* bias; PanelStats st; unsigned poison;
    __device__ __forceinline__ void fused(f32x4 (&acc)[2][2][4][2], const Unit& u, int wr, int wc, int fr, int fq, PG8_LAS unsigned char* lds, int wid, int lane) const {
        typedef float f32x2v __attribute__((ext_vector_type(2)));
        const PG8_LAS f32x2v* S = (const PG8_LAS f32x2v*)(lds + 8192);
        const int col0 = u.pn * BM + wc * 32 + 4 * fq;
#pragma unroll
        for (int bj = 0; bj < 2; ++bj)
#pragma unroll
            for (int n = 0; n < 2; ++n) { const f32x4 bv = bias ? *(const f32x4*)(bias + col0 + bj * HALF + n * 16) : (f32x4){0.f, 0.f, 0.f, 0.f};
#pragma unroll
                for (int ai = 0; ai < 2; ++ai)
#pragma unroll
                    for (int m = 0; m < 4; ++m) acc[ai][bj][m][n] += bv; }
        f32x4 pre[4][2][2];
#pragma unroll
        for (int m = 0; m < 4; ++m) { const size_t off = (size_t)(u.pm * BM + wr * 64 + m * 16 + fr) * ldc + col0;
#pragma unroll
            for (int bj = 0; bj < 2; ++bj)
#pragma unroll
                for (int n = 0; n < 2; ++n) pre[m][bj][n] = *(const f32x4*)(base + off + bj * HALF + n * 16); }
        const bool bad = st.run(acc, u, wr, wc, fr, fq, lds, wid, lane) || poison != 0u;
        const float qnan = __builtin_nanf("");
#pragma unroll
        for (int ai = 0; ai < 2; ++ai)
#pragma unroll
            for (int m = 0; m < 4; ++m) { const int r = ai * HALF + wr * 64 + m * 16 + fr; const f32x2v sr = S[r]; const size_t off = (size_t)(u.pm * BM + r) * ldc + col0;
#pragma unroll
                for (int bj = 0; bj < 2; ++bj)
#pragma unroll
                    for (int n = 0; n < 2; ++n) { const f32x4 bs = ai == 0 ? pre[m][bj][n] : *(const f32x4*)(base + off + bj * HALF + n * 16); f32x4 o = bs + (acc[ai][bj][m][n] - sr.x) * sr.y;
                        if (bad) o = (f32x4){qnan, qnan, qnan, qnan}; *(f32x4*)(out + off + bj * HALF + n * 16) = o; }
                if (m & 1) asm volatile("" ::: "memory"); }
    }
};
struct EpiLnResLn {
    static constexpr bool PERM = false, AFTER_DRAIN = true;
    const float* base; float* out; bf16_t* xn; int ldc; const float* bias; PanelStats st1, st2; unsigned poison;
    __device__ __forceinline__ void fused(f32x4 (&acc)[2][2][4][2], const Unit& u, int wr, int wc, int fr, int fq, PG8_LAS unsigned char* lds, int wid, int lane) const {
        typedef float f32x2v __attribute__((ext_vector_type(2))); typedef unsigned u32x2v __attribute__((ext_vector_type(2)));
        const PG8_LAS f32x2v* S = (const PG8_LAS f32x2v*)(lds + 8192);
        const int col0 = u.pn * BM + wc * 32 + 4 * fq;
#pragma unroll
        for (int bj = 0; bj < 2; ++bj)
#pragma unroll
            for (int n = 0; n < 2; ++n) { const f32x4 bv = bias ? *(const f32x4*)(bias + col0 + bj * HALF + n * 16) : (f32x4){0.f, 0.f, 0.f, 0.f};
#pragma unroll
                for (int ai = 0; ai < 2; ++ai)
#pragma unroll
                    for (int m = 0; m < 4; ++m) acc[ai][bj][m][n] += bv; }
        bool bad = st1.run(acc, u, wr, wc, fr, fq, lds, wid, lane) || poison != 0u;
        const float qnan = __builtin_nanf("");
#pragma unroll
        for (int ai = 0; ai < 2; ++ai)
#pragma unroll
            for (int m = 0; m < 4; ++m) { const int r = ai * HALF + wr * 64 + m * 16 + fr; const f32x2v sr = S[r]; const size_t off = (size_t)(u.pm * BM + r) * ldc + col0;
#pragma unroll
                for (int bj = 0; bj < 2; ++bj)
#pragma unroll
                    for (int n = 0; n < 2; ++n) { const f32x4 bs = *(const f32x4*)(base + off + bj * HALF + n * 16); acc[ai][bj][m][n] = bs + (acc[ai][bj][m][n] - sr.x) * sr.y; }
                asm volatile("" : "+v"(acc[ai][0][m][0]), "+v"(acc[ai][0][m][1]), "+v"(acc[ai][1][m][0]), "+v"(acc[ai][1][m][1]));
                if (m & 1) asm volatile("" ::: "memory"); }
        const bool bad1 = bad;
        bad = st2.run(acc, u, wr, wc, fr, fq, lds, wid, lane) || bad;
#pragma unroll
        for (int ai = 0; ai < 2; ++ai)
#pragma unroll
            for (int m = 0; m < 4; ++m) { const int r = ai * HALF + wr * 64 + m * 16 + fr; const f32x2v sr = S[r]; const size_t off = (size_t)(u.pm * BM + r) * ldc + col0;
#pragma unroll
                for (int bj = 0; bj < 2; ++bj)
#pragma unroll
                    for (int n = 0; n < 2; ++n) { const f32x4 x1 = acc[ai][bj][m][n]; *(f32x4*)(out + off + bj * HALF + n * 16) = bad1 ? (f32x4){qnan, qnan, qnan, qnan} : x1;
                        const f32x4 o = (x1 - sr.x) * sr.y; u32x2v w; w.x = cvt_pk_bf16(o[0], o[1]); w.y = cvt_pk_bf16(o[2], o[3]);
                        if (bad) { w.x = 0x7fc07fc0u; w.y = 0x7fc07fc0u; } *(u32x2v*)(xn + off + bj * HALF + n * 16) = w; }
                asm volatile("" ::: "memory"); }
    }
};

template <class Epi, class Sched, bool ALIGN_EPI = false, bool SP2 = false>
__device__ __forceinline__ void gemm_phase(PG8_LAS unsigned char* lds, const Gemm g, const Sched& S, const Epi& E) {
    const int tid = threadIdx.x, wid = __builtin_amdgcn_readfirstlane(tid >> 6), lane = tid & 63, wr = wid >> 2, wc = wid & 3, fr = lane & 15, fq = lane >> 4;
    const int K = g.K, nt = K / BK;
    unsigned voffA[2], voffB[2];
#pragma unroll
    for (int i = 0; i < 2; ++i) { int R, C; stage_rc(tid * 16 + i * 8192, R, C); const int Rb = Epi::PERM ? ((R & ~31) + perm32(R & 31)) : R;
        voffA[i] = (unsigned)(R * K + C) * 2u; voffB[i] = (unsigned)(Rb * K + C) * 2u; }
    const size_t kstep = (size_t)(BK * 2);
    const size_t hstep = (size_t)HALF * K * 2;
    const size_t tstep = 2 * hstep;
    const unsigned ldsw = (unsigned)wid * 1024u;
    const int aoff = lds_byte(wr * 64 + fr, fq * 8), boff = lds_byte(wc * 32 + fr, fq * 8);
#define PG8_SA(b, h) (((b) * 2 + (h)) * HTB)
#define PG8_SB(b, h) ((4 + (b) * 2 + (h)) * HTB)
#define PG8_STAGE(bufoff, gbase, voff) do { _Pragma("unroll") for (int _i = 0; _i < 2; ++_i) \
        __builtin_amdgcn_global_load_lds((const unsigned*)((const char*)(gbase) + (voff)[_i]), (PG8_LAS unsigned*)(lds + (bufoff) + ldsw + _i * 8192), 16, 0, 0); } while (0)
#define PG8_LDA(dst, b, h) do { _Pragma("unroll") for (int m = 0; m < 4; ++m) _Pragma("unroll") for (int k = 0; k < 2; ++k) dst[m][k] = *(const PG8_LAS bf16x8*)(lds + PG8_SA(b, h) + aoff + m * 2048 + k * 1024); } while (0)
#define PG8_LDB(dst, b, h) do { _Pragma("unroll") for (int n = 0; n < 2; ++n) _Pragma("unroll") for (int k = 0; k < 2; ++k) dst[n][k] = *(const PG8_LAS bf16x8*)(lds + PG8_SB(b, h) + boff + n * 2048 + k * 1024); } while (0)
#define PG8_MMA(ai, bj, At, Bt) do { __builtin_amdgcn_s_setprio(1); _Pragma("unroll") for (int m = 0; m < 4; ++m) _Pragma("unroll") for (int n = 0; n < 2; ++n) _Pragma("unroll") for (int k = 0; k < 2; ++k) \
        acc[ai][bj][m][n] = __builtin_amdgcn_mfma_f32_16x16x32_bf16(Bt[n][k], At[m][k], acc[ai][bj][m][n], 0, 0, 0); __builtin_amdgcn_s_setprio(0); } while (0)
#define PG8_WAIT_V(n) asm volatile("s_waitcnt vmcnt(" #n ")" ::: "memory")
#define PG8_WAIT_L(n) asm volatile("s_waitcnt lgkmcnt(" #n ")" ::: "memory")
#define PG8_BAR __builtin_amdgcn_s_barrier()
#define PG8_SCHED __builtin_amdgcn_sched_barrier(0)
    Unit cur, nxt; int ui = 0;
    if (!S.next(0, cur)) return;
    f32x4 acc[2][2][4][2];
#pragma unroll
    for (int a = 0; a < 2; ++a)
#pragma unroll
        for (int b = 0; b < 2; ++b)
#pragma unroll
            for (int m = 0; m < 4; ++m)
#pragma unroll
                for (int n = 0; n < 2; ++n) acc[a][b][m][n] = (f32x4){0.f, 0.f, 0.f, 0.f};
    bf16x8 At[4][2], B0[2][2], B1[2][2];
    const char* cA = (const char*)g.A + (size_t)cur.pm * tstep; const char* cB = (const char*)g.Bt + (size_t)cur.pn * tstep;
    S.a_ready(cur);
    if constexpr (SP2) {
        PG8_STAGE(PG8_SB(0, 0), cB, voffB); PG8_STAGE(PG8_SB(0, 1), cB + hstep, voffB); PG8_STAGE(PG8_SA(0, 0), cA, voffA); PG8_STAGE(PG8_SA(0, 1), cA + hstep, voffA);
        if (wr == 1) PG8_BAR;
        PG8_WAIT_V(2); PG8_BAR;
        PG8_STAGE(PG8_SB(1, 0), cB + kstep, voffB); PG8_STAGE(PG8_SA(1, 0), cA + kstep, voffA); PG8_STAGE(PG8_SB(1, 1), cB + hstep + kstep, voffB);
        PG8_WAIT_V(6); PG8_BAR;
    } else {
        PG8_STAGE(PG8_SB(0, 0), cB, voffB); PG8_STAGE(PG8_SA(0, 0), cA, voffA); PG8_STAGE(PG8_SB(0, 1), cB + hstep, voffB); PG8_STAGE(PG8_SA(0, 1), cA + hstep, voffA);
        if (wr == 1) PG8_BAR;
        PG8_WAIT_V(4); PG8_BAR;
        PG8_STAGE(PG8_SB(1, 0), cB + kstep, voffB); PG8_STAGE(PG8_SA(1, 0), cA + kstep, voffA); PG8_STAGE(PG8_SB(1, 1), cB + hstep + kstep, voffB);
        PG8_WAIT_V(6); PG8_BAR;
    }
    for (;;) {
        const bool has_next = S.next(ui + 1, nxt);
        const char* nA = has_next ? (const char*)g.A + (size_t)nxt.pm * tstep : cA; const char* nB = has_next ? (const char*)g.Bt + (size_t)nxt.pn * tstep : cB;
        for (int t = 0; t < nt; t += 2) {
            const bool last = (t == nt - 2);
            const char* a1 = cA + (size_t)(t + 1) * kstep;
            const char* a2 = last ? nA : cA + (size_t)(t + 2) * kstep; const char* b2 = last ? nB : cB + (size_t)(t + 2) * kstep;
            const char* a3 = a2 + kstep; const char* b3 = b2 + kstep;
            if (last && has_next) S.a_ready(nxt);
            if constexpr (SP2) {
            PG8_LDB(B0, 0, 0); PG8_LDB(B1, 0, 1); PG8_SCHED; PG8_LDA(At, 0, 0); PG8_STAGE(PG8_SA(1, 1), a1 + hstep, voffA);
            PG8_WAIT_V(8); PG8_WAIT_L(0); PG8_BAR; PG8_MMA(0, 0, At, B0); PG8_MMA(0, 1, At, B1); PG8_BAR; PG8_SCHED;
            PG8_LDA(At, 0, 1); PG8_STAGE(PG8_SB(0, 0), b2, voffB); PG8_STAGE(PG8_SB(0, 1), b2 + hstep, voffB); PG8_STAGE(PG8_SA(0, 0), a2, voffA);
            PG8_WAIT_V(8); PG8_WAIT_L(0); PG8_BAR; PG8_MMA(1, 0, At, B0); PG8_MMA(1, 1, At, B1); PG8_BAR; PG8_SCHED;
            PG8_LDB(B0, 1, 0); PG8_LDB(B1, 1, 1); PG8_SCHED; PG8_LDA(At, 1, 0); PG8_STAGE(PG8_SA(0, 1), a2 + hstep, voffA);
            PG8_WAIT_V(8); PG8_WAIT_L(0); PG8_BAR; PG8_MMA(0, 0, At, B0); PG8_MMA(0, 1, At, B1); PG8_BAR; PG8_SCHED;
            PG8_LDA(At, 1, 1); PG8_STAGE(PG8_SB(1, 0), b3, voffB); PG8_STAGE(PG8_SB(1, 1), b3 + hstep, voffB); PG8_STAGE(PG8_SA(1, 0), a3, voffA);
            PG8_WAIT_V(8); PG8_WAIT_L(0); PG8_BAR; PG8_MMA(1, 0, At, B0); PG8_MMA(1, 1, At, B1); PG8_BAR; PG8_SCHED;
            } else {
            PG8_LDB(B0, 0, 0); PG8_SCHED; PG8_LDA(At, 0, 0); PG8_STAGE(PG8_SA(1, 1), a1 + hstep, voffA);
            PG8_WAIT_L(8); PG8_BAR; PG8_WAIT_L(0); PG8_MMA(0, 0, At, B0); PG8_BAR; PG8_SCHED;
            PG8_LDB(B1, 0, 1); PG8_STAGE(PG8_SB(0, 0), b2, voffB);
            PG8_BAR; PG8_WAIT_L(0); PG8_MMA(0, 1, At, B1); PG8_BAR;
            PG8_LDA(At, 0, 1); PG8_STAGE(PG8_SA(0, 0), a2, voffA);
            PG8_BAR; PG8_WAIT_L(0); PG8_MMA(1, 0, At, B0); PG8_BAR; PG8_SCHED;
            PG8_STAGE(PG8_SB(0, 1), b2 + hstep, voffB);
            PG8_WAIT_V(6); PG8_BAR; PG8_MMA(1, 1, At, B1); PG8_BAR;
            PG8_LDB(B0, 1, 0); PG8_SCHED; PG8_LDA(At, 1, 0); PG8_STAGE(PG8_SA(0, 1), a2 + hstep, voffA);
            PG8_WAIT_L(8); PG8_BAR; PG8_WAIT_L(0); PG8_MMA(0, 0, At, B0); PG8_BAR; PG8_SCHED;
            PG8_LDB(B1, 1, 1); PG8_STAGE(PG8_SB(1, 0), b3, voffB);
            PG8_BAR; PG8_WAIT_L(0); PG8_MMA(0, 1, At, B1); PG8_BAR;
            PG8_LDA(At, 1, 1); PG8_STAGE(PG8_SA(1, 0), a3, voffA);
            PG8_BAR; PG8_WAIT_L(0); PG8_MMA(1, 0, At, B0); PG8_BAR; PG8_SCHED;
            PG8_STAGE(PG8_SB(1, 1), b3 + hstep, voffB);
            PG8_WAIT_V(6); PG8_BAR; PG8_MMA(1, 1, At, B1); PG8_BAR;
            }
        }
        if constexpr (ALIGN_EPI) { if (wr == 0) PG8_BAR; }
        if constexpr (!Epi::AFTER_DRAIN) { E(acc, cur, wr, wc, fr, fq); S.done(cur); }
        if (!has_next) break;
#pragma unroll
        for (int a = 0; a < 2; ++a)
#pragma unroll
            for (int b = 0; b < 2; ++b)
#pragma unroll
                for (int m = 0; m < 4; ++m)
#pragma unroll
                    for (int n = 0; n < 2; ++n) acc[a][b][m][n] = (f32x4){0.f, 0.f, 0.f, 0.f};
        cur = nxt; cA = nA; cB = nB; ++ui;
        if constexpr (ALIGN_EPI) { if (wr == 1) PG8_BAR; }
    }
    PG8_WAIT_V(0);
    if constexpr (!ALIGN_EPI) { if (wr == 0) PG8_BAR; }
    PG8_BAR;
    if constexpr (Epi::AFTER_DRAIN) { E.fused(acc, cur, wr, wc, fr, fq, lds, wid, lane); S.done(cur); }
#undef PG8_SA
#undef PG8_SB
#undef PG8_STAGE
#undef PG8_LDA
#undef PG8_LDB
#undef PG8_MMA
#undef PG8_WAIT_V
#undef PG8_WAIT_L
#undef PG8_BAR
#undef PG8_SCHED
}
}


constexpr int BATCH = 8, SEQ = 4096, DM = 1024, MTOK = BATCH * SEQ;
constexpr int NH = 8, HD = 64;
constexpr int NPROJ = 4224, NPROJ_PAD = 4352;
constexpr int C_R = 0, C_K = 512, C_V = 1024, C_Q = 1536, C_KA = 2048, C_VA = 2560, C_G = 3072, C_WD = 4096, C_AD = 4160;
__host__ __device__ __forceinline__ int oldcol(int n) { return n < 1536 ? n : (n < 4096 ? n + 128 : n - 2560); }
constexpr float RMS_EPS = 1e-6f, GN_EPS = 64e-5f;

#define GAS __attribute__((address_space(1)))
#define LAS __attribute__((address_space(3)))
typedef unsigned short bf16;
typedef unsigned v4u __attribute__((ext_vector_type(4)));
typedef float f32x4 __attribute__((ext_vector_type(4)));
__device__ __forceinline__ unsigned f2bf(float f) { unsigned u = __builtin_bit_cast(unsigned, f); return (u + 0x7fffu + ((u >> 16) & 1u)) >> 16; }
__device__ __forceinline__ unsigned pk2(float lo, float hi) { return f2bf(lo) | (f2bf(hi) << 16); }
__device__ __forceinline__ float bf2f(bf16 v) { return __builtin_bit_cast(float, (unsigned)v << 16); }
__device__ __forceinline__ float wave_sum(float v) {
#pragma unroll
    for (int o = 1; o < 64; o <<= 1) v += __shfl_xor(v, o);
    return v;
}
__device__ __forceinline__ float wave_max(float v) {
#pragma unroll
    for (int o = 1; o < 64; o <<= 1) v = fmaxf(v, __shfl_xor(v, o));
    return v;
}
#define LDS_WAIT() asm volatile("s_waitcnt lgkmcnt(0)" ::: "memory")

constexpr size_t MiB = 1u << 20;
constexpr size_t WS_CTL = 0;
constexpr size_t WS_WIN = 2 * MiB;
constexpr size_t WS_WOUT = 11 * MiB;
constexpr size_t WS_KMEAN = 13 * MiB;
constexpr size_t WS_W2T = 13 * MiB + 512 * 1024, WS_A2T = WS_W2T + 65536;
constexpr size_t WS_XN = 16 * MiB;
constexpr size_t WS_MF = 16 * MiB;
constexpr size_t WS_RKV = 80 * MiB;
constexpr size_t WS_YBUF = 80 * MiB;
constexpr size_t WS_WDAD = 176 * MiB;
constexpr size_t WS_QKVA = 184 * MiB;
constexpr size_t WS_GATES = 280 * MiB;
constexpr size_t WS_NA = 344 * MiB, WS_PF = 408 * MiB, WS_QA = 440 * MiB, WS_BV = 472 * MiB;
constexpr size_t WS_WDAD2 = 504 * MiB;
constexpr size_t WS_OBUF = 208 * MiB;
constexpr size_t WS_END = 512 * MiB;

__device__ __forceinline__ void p0_transpose_item(const float* W, int K, int N, bf16* WT, bool perm, LAS float* scr, int item, int lane) {
    const int nblk_new = perm ? (NPROJ / 32) : (N / 32);
    const int kb = item / nblk_new, nb = item % nblk_new, k0 = 64 * kb, n0new = 32 * nb, n0 = perm ? oldcol(n0new) : n0new;
#pragma unroll 8
    for (int i = 0; i < 32; ++i) { const int kk = 2 * i + (lane >> 5); scr[kk * 33 + (lane & 31)] = W[(size_t)(k0 + kk) * N + n0 + (lane & 31)]; }
    LDS_WAIT(); asm volatile("" ::: "memory");
    const int c = lane & 7;
#pragma unroll
    for (int j = 0; j < 4; ++j) { const int n = (lane >> 3) + 8 * j; const LAS float* s = scr + (8 * c) * 33 + n;
        v4u o; o.x = pk2(s[0 * 33], s[1 * 33]); o.y = pk2(s[2 * 33], s[3 * 33]); o.z = pk2(s[4 * 33], s[5 * 33]); o.w = pk2(s[6 * 33], s[7 * 33]);
        *(GAS v4u*)(WT + (size_t)(n0new + n) * K + k0 + 8 * c) = o; }
    LDS_WAIT(); asm volatile("" ::: "memory");
}
__device__ __forceinline__ void rms_row_to_bf16(const float* xrow, const float* g, bf16* orow, int lane) {
    const GAS f32x4* xr = (const GAS f32x4*)xrow + lane;
    const GAS f32x4* gr = (const GAS f32x4*)g + lane;
    f32x4 v[4]; float s = 0.f;
#pragma unroll
    for (int j = 0; j < 4; ++j) { v[j] = xr[64 * j]; s += (v[j].x * v[j].x + v[j].y * v[j].y) + (v[j].z * v[j].z + v[j].w * v[j].w); }
    const float rs = 1.f / sqrtf(wave_sum(s) * (1.f / DM) + RMS_EPS);
    GAS unsigned long long* o8 = (GAS unsigned long long*)orow + lane;
#pragma unroll
    for (int j = 0; j < 4; ++j) { const f32x4 gg = gr[64 * j];
        o8[64 * j] = (unsigned long long)pk2(v[j].x * rs * gg.x, v[j].y * rs * gg.y) | ((unsigned long long)pk2(v[j].z * rs * gg.z, v[j].w * rs * gg.w) << 32); }
}

#define XB_TMO      128
#define XB_XCNT(j)  (256  + 64 * (j))
#define XB_XSUB(j)  (1280 + 64 * (j))
#define XB_XGEN(j)  (2304 + 64 * (j))
#define XB_TOP      3328
#define XB_TOPGEN   3392
#define XCD_BAR_WORDS 3456
#define XB_SPIN_CAP (1u << 18)

__device__ __forceinline__ unsigned xb_ld(unsigned* p)              { return __hip_atomic_load(p, __ATOMIC_RELAXED, __HIP_MEMORY_SCOPE_AGENT); }
__device__ __forceinline__ unsigned xb_add(unsigned* p, unsigned v) { return __hip_atomic_fetch_add(p, v, __ATOMIC_RELAXED, __HIP_MEMORY_SCOPE_AGENT); }
__device__ __forceinline__ unsigned xb_xcc_id() { return (unsigned)__builtin_amdgcn_s_getreg((3 << 11) | 20) & 0xFu; }
#define XB_SPIN(cond, bar) do { unsigned _sp = 0; while (cond) { __builtin_amdgcn_s_sleep(1); \
    if ((++_sp & 255u) == 0u) { if (xb_ld(&(bar)[XB_TMO])) break; if (_sp > XB_SPIN_CAP) { atomicAdd(&(bar)[XB_TMO], 1u); break; } } } } while (0)

struct XcdBarrier {
    unsigned* bar; unsigned x;
    volatile LAS unsigned* st;
};

__device__ __forceinline__ XcdBarrier xcd_barrier_post(unsigned* bar, volatile LAS unsigned* st) {
    XcdBarrier b; b.bar = bar; b.x = xb_xcc_id(); b.st = st;
    if (threadIdx.x == 0) (void)xb_add(&bar[XB_XCNT(b.x)], 1u);
    return b;
}
__device__ __forceinline__ void xcd_barrier_complete(unsigned* bar, unsigned x, unsigned& nloc, unsigned& nx) {
    const unsigned G = gridDim.x * gridDim.y * gridDim.z;
    unsigned sum, cnt, mine, sp = 0u;
    for (;;) {
        sum = 0u; cnt = 0u; mine = 0u;
#pragma unroll
        for (unsigned j = 0; j < 16; ++j) { const unsigned c = xb_ld(&bar[XB_XCNT(j)]); sum += c; cnt += (c > 0u) ? 1u : 0u; mine = (j == x) ? c : mine; }
        if (sum == G) break;
        __builtin_amdgcn_s_sleep(1);
        if ((++sp & 255u) == 0u) { if (xb_ld(&bar[XB_TMO])) break; if (sp > XB_SPIN_CAP) { atomicAdd(&bar[XB_TMO], 1u); break; } }
    }
    nloc = mine > 0u ? mine : 1u; nx = cnt > 0u ? cnt : 1u;
}

__device__ __forceinline__ void xcd_barrier(const XcdBarrier& b) {
    asm volatile("s_waitcnt vmcnt(0)" ::: "memory");
    __syncthreads();
    if (threadIdx.x == 0) {
        unsigned* bar = b.bar;
        __builtin_amdgcn_s_waitcnt(0);
        unsigned nloc = b.st[0], nx = b.st[1];
        if (nloc == 0u) { xcd_barrier_complete(bar, b.x, nloc, nx); b.st[0] = nloc; b.st[1] = nx; }
        const unsigned old = xb_add(&bar[XB_XSUB(b.x)], 1u);
        const unsigned gen = old / nloc;
        if (old + 1u == (gen + 1u) * nloc) {
            __builtin_amdgcn_fence(__ATOMIC_RELEASE, "agent");
            asm volatile("s_waitcnt vmcnt(0)" ::: "memory");
            const unsigned og = xb_add(&bar[XB_TOP], 1u);
            const unsigned tg = og / nx;
            if (og + 1u == (tg + 1u) * nx) xb_add(&bar[XB_TOPGEN], 1u);
            else XB_SPIN(xb_ld(&bar[XB_TOPGEN]) == tg, bar);
            __builtin_amdgcn_fence(__ATOMIC_ACQUIRE, "agent");
            xb_add(&bar[XB_XGEN(b.x)], 1u);
            asm volatile("s_waitcnt vmcnt(0)" ::: "memory");
        } else {
            XB_SPIN(xb_ld(&bar[XB_XGEN(b.x)]) == gen, bar);
            __builtin_amdgcn_fence(__ATOMIC_ACQUIRE, "agent");
            asm volatile("s_waitcnt vmcnt(0)" ::: "memory");
        }
    }
    __syncthreads();
}


constexpr int NWAVES = 8;
constexpr int RING_OFF = 0, RING_BYTES = 131072;
constexpr int LDSCTL_OFF = 147456 - 512, MISC_OFF = LDSCTL_OFF + 320;
constexpr int LDS_BYTES = 147456;
constexpr size_t CTL_ZERO_BYTES = 1 * MiB;
constexpr int CW_BAR = 4096;
constexpr int CW_QUEUE = 64;
typedef GAS unsigned gu32;
#define RLX_AGENT __ATOMIC_RELAXED, __HIP_MEMORY_SCOPE_AGENT

struct Args { const float* in[15]; float* out; unsigned char* ws; };

__device__ __forceinline__ void phase_prologue(const Args& a, LAS unsigned char* lds, int tid, int lane, int wave) {
    LAS float* scr = (LAS float*)(lds + wave * 16384);
    const int gw = blockIdx.x * 8 + wave, NGW = gridDim.x * 8;
    bf16* WinT = (bf16*)(a.ws + WS_WIN); bf16* WoutT = (bf16*)(a.ws + WS_WOUT); bf16* XN = (bf16*)(a.ws + WS_XN);
    constexpr int I_IN = (DM / 64) * (NPROJ / 32), I_OUT = (DM / 64) * (DM / 32);
    for (int it = gw; it < I_IN + I_OUT; it += NGW) {
        if (it < I_IN) p0_transpose_item(a.in[2], DM, NPROJ, WinT, true, scr, it, lane);
        else p0_transpose_item(a.in[13], DM, DM, WoutT, false, scr, it - I_IN, lane);
    }
    { v4u z = {0u, 0u, 0u, 0u}; GAS v4u* p = (GAS v4u*)(WinT + (size_t)NPROJ * DM);
      for (int i = blockIdx.x * 512 + tid; i < 128 * 1024 * 2 / 16; i += gridDim.x * 512) p[i] = z; }
    { bf16* W2T = (bf16*)(a.ws + WS_W2T); bf16* A2T = (bf16*)(a.ws + WS_A2T);
      for (int i = blockIdx.x * 512 + tid; i < 512 * 64; i += gridDim.x * 512) { const int ch = i >> 6, j = i & 63; W2T[i] = (bf16)f2bf(a.in[5][j * 512 + ch]); A2T[i] = (bf16)f2bf(a.in[7][j * 512 + ch]); } }
    for (int m = gw; m < MTOK; m += NGW) rms_row_to_bf16(a.in[0] + (size_t)m * DM, a.in[1], XN + (size_t)m * DM, lane);
}

__device__ __forceinline__ void phase_final(const Args& a, int lane, int wave) {
    const int gw = blockIdx.x * 8 + wave, NGW = gridDim.x * 8;
    const float* O = (const float*)(a.ws + WS_OBUF);
    for (int m = gw; m < MTOK; m += NGW) {
        const f32x4* orow = (const f32x4*)(O + (size_t)m * DM) + lane; const f32x4* xr = (const f32x4*)(a.in[0] + (size_t)m * DM) + lane; const f32x4* gr = (const f32x4*)a.in[14] + lane;
        f32x4 v[4]; float s = 0.f;
#pragma unroll
        for (int j = 0; j < 4; ++j) { v[j] = orow[64 * j]; s += (v[j].x * v[j].x + v[j].y * v[j].y) + (v[j].z * v[j].z + v[j].w * v[j].w); }
        const float rs = 1.f / sqrtf(wave_sum(s) * (1.f / DM) + RMS_EPS);
        f32x4* outr = (f32x4*)(a.out + (size_t)m * DM) + lane;
#pragma unroll
        for (int j = 0; j < 4; ++j) outr[64 * j] = xr[64 * j] + v[j] * rs * gr[64 * j];
    }
}

__device__ __forceinline__ void phase_kmean(const Args& a, int tid) {
    const bf16* qkva = (const bf16*)(a.ws + WS_QKVA); float* km = (float*)(a.ws + WS_KMEAN);
    for (int u = blockIdx.x; u < BATCH * 16; u += gridDim.x) {
        const int b = u / 16, n = u % 16, c = tid;
        const bf16* p = qkva + ((size_t)b * SEQ + n * 256) * 1536 + 512 + c;
        float s = 0.f;
        for (int t = 0; t < 256; ++t) s += bf2f(p[(size_t)t * 1536]);
        km[(((size_t)b * NH + (c >> 6)) * 16 + n) * 64 + (c & 63)] = s * (1.f / 256.f);
    }
}

#define WAVE_LDS_SYNC() do { asm volatile("s_waitcnt lgkmcnt(0)" ::: "memory"); } while (0)

__device__ __forceinline__ void moba_simple_item(const Args& a, int item, LAS float* scr, int lane) {
    LAS float* s_q = scr; LAS float* s_g = scr + 64; LAS float* s_l = scr + 128;
    const bf16* qkva = (const bf16*)(a.ws + WS_QKVA); const float* km = (const float*)(a.ws + WS_KMEAN); bf16* ybuf = (bf16*)(a.ws + WS_YBUF);
    const int h = item & 7, m = item >> 3, b = m / SEQ, t = m % SEQ, qb = t >> 8;
    const bf16* row = qkva + (size_t)m * 1536;
    s_q[lane] = bf2f(row[h * 64 + lane]) * 0.125f;
    WAVE_LDS_SYNC();
    float q[64];
#pragma unroll
    for (int d = 0; d < 64; ++d) q[d] = s_q[d];
    if (lane < 16) { float g = -1e30f; if (lane < qb) { g = 0.f; const float* kp = km + (((size_t)b * NH + h) * 16 + lane) * 64;
#pragma unroll
            for (int d = 0; d < 64; ++d) g += q[d] * kp[d]; }
        s_g[lane] = g; }
    WAVE_LDS_SYNC();
    int sel0, sel1, sel2; { float g[16]; int sl[3];
#pragma unroll
        for (int i = 0; i < 16; ++i) g[i] = s_g[i];
#pragma unroll
        for (int k = 0; k < 3; ++k) { int bi = 0; float bv = g[0];
#pragma unroll
            for (int i = 1; i < 16; ++i) if (g[i] > bv) { bv = g[i]; bi = i; }
            sl[k] = bi;
#pragma unroll
            for (int i = 0; i < 16; ++i) if (i == bi) g[i] = -3e38f; }
        sel0 = sl[0]; sel1 = sl[1]; sel2 = sl[2]; }
    const int nv = qb < 3 ? qb : 3;
    const float slope = exp2f(-(float)(h + 1));
    const bf16* kbase = qkva + (size_t)b * SEQ * 1536 + 512 + h * 64;
    const bf16* vbase = qkva + (size_t)b * SEQ * 1536 + 1024 + h * 64;
    float mx = -1e30f;
    for (int blk = 0; blk < 4; ++blk) {
        const bool own = (blk == 3); if (!own && blk >= nv) { for (int i = 0; i < 4; ++i) s_l[blk * 256 + lane + 64 * i] = -1e30f; continue; }
        const int kb = own ? qb : (blk == 0 ? sel0 : (blk == 1 ? sel1 : sel2));
        for (int i = 0; i < 4; ++i) { const int s = kb * 256 + lane + 64 * i; const v4u* kr = (const v4u*)(kbase + (size_t)s * 1536);
            float dot = 0.f;
#pragma unroll
            for (int c8 = 0; c8 < 8; ++c8) { const v4u kk = kr[c8];
                dot += q[c8 * 8 + 0] * __builtin_bit_cast(float, kk.x << 16) + q[c8 * 8 + 1] * __builtin_bit_cast(float, kk.x & 0xffff0000u)
                     + q[c8 * 8 + 2] * __builtin_bit_cast(float, kk.y << 16) + q[c8 * 8 + 3] * __builtin_bit_cast(float, kk.y & 0xffff0000u)
                     + q[c8 * 8 + 4] * __builtin_bit_cast(float, kk.z << 16) + q[c8 * 8 + 5] * __builtin_bit_cast(float, kk.z & 0xffff0000u)
                     + q[c8 * 8 + 6] * __builtin_bit_cast(float, kk.w << 16) + q[c8 * 8 + 7] * __builtin_bit_cast(float, kk.w & 0xffff0000u); }
            float lg = dot - slope * (float)(t - s);
            if (own && s > t) lg = -1e30f;
            s_l[blk * 256 + lane + 64 * i] = lg; mx = fmaxf(mx, lg); }
    }
    mx = wave_max(mx);
    WAVE_LDS_SYNC();
    float sum = 0.f;
    for (int i = 0; i < 16; ++i) { const float l = s_l[lane + 64 * i]; const float p = (l <= -1e29f) ? 0.f : __expf(l - mx); s_l[lane + 64 * i] = p; sum += p; }
    sum = wave_sum(sum);
    WAVE_LDS_SYNC();
    float o = 0.f;
    for (int blk = 0; blk < 4; ++blk) {
        const bool own = (blk == 3); if (!own && blk >= nv) continue;
        const int kb = own ? qb : (blk == 0 ? sel0 : (blk == 1 ? sel1 : sel2)); const int lim = own ? (t - kb * 256 + 1) : 256;
        const bf16* vp = vbase + (size_t)(kb * 256) * 1536 + lane;
        for (int s = 0; s < lim; ++s) o += s_l[blk * 256 + s] * bf2f(vp[(size_t)s * 1536]);
    }
    const float gt = bf2f(((const bf16*)(a.ws + WS_GATES))[(size_t)m * 1024 + 512 + h * 64 + lane]);
    const float y = (o / sum) * gt / (1.f + __expf(-gt));
    ybuf[(size_t)m * DM + 512 + h * 64 + lane] = (bf16)f2bf(y);
    WAVE_LDS_SYNC();
}


typedef float f32x16 __attribute__((ext_vector_type(16)));
typedef short bf16x8_t __attribute__((ext_vector_type(8)));
typedef unsigned u32x4_t __attribute__((ext_vector_type(4)));
typedef unsigned u32x2_t __attribute__((ext_vector_type(2)));
struct P8 { unsigned w[8]; };
#define MFMA32(a, b, c) __builtin_amdgcn_mfma_f32_32x32x16_bf16((a), (b), (c), 0, 0, 0)
__device__ __forceinline__ unsigned cvtpk(float lo, float hi) { typedef float f2 __attribute__((ext_vector_type(2))); typedef __bf16 b2 __attribute__((ext_vector_type(2))); f2 v = {lo, hi}; b2 b = __builtin_convertvector(v, b2); return __builtin_bit_cast(unsigned, b); }
__device__ __forceinline__ float bflo(unsigned u) { return __builtin_bit_cast(float, u << 16); }
__device__ __forceinline__ float bfhi(unsigned u) { return __builtin_bit_cast(float, u & 0xffff0000u); }
__device__ __forceinline__ P8 pack_tile(const f32x16& x) { P8 p;
#pragma unroll
    for (int q = 0; q < 8; ++q) p.w[q] = cvtpk(x[2 * q], x[2 * q + 1]);
    return p; }
__device__ __forceinline__ f32x16 unpack_tile(const P8& p) { f32x16 x;
#pragma unroll
    for (int q = 0; q < 8; ++q) { x[2 * q] = bflo(p.w[q]); x[2 * q + 1] = bfhi(p.w[q]); }
    return x; }
template <int S> __device__ __forceinline__ bf16x8_t frag(const P8& p) { u32x4_t v = {p.w[4 * S], p.w[4 * S + 1], p.w[4 * S + 2], p.w[4 * S + 3]}; return __builtin_bit_cast(bf16x8_t, v); }
__device__ __forceinline__ f32x16 zero16() { f32x16 z;
#pragma unroll
    for (int i = 0; i < 16; ++i) z[i] = 0.f;
    return z; }
__device__ __forceinline__ f32x16 mm1(const P8& a, const P8& b, f32x16 acc) { acc = MFMA32(frag<0>(a), frag<0>(b), acc); acc = MFMA32(frag<1>(a), frag<1>(b), acc); return acc; }

constexpr int RW_NUNITS = BATCH * NH * (SEQ / 32);
constexpr size_t RW_MF_BYTES = 8192, RW_NA_BYTES = 8192, RW_PF_BYTES = 4096, RW_QA_BYTES = 4096, RW_BV_BYTES = 4096;
constexpr int PT_MU = 0, PT_W0 = 1664, PT_A0 = 2176, PT_KK = 2688, PT_KA = 3200, PT_RK = 3712, PT_FLOATS = 4224;
constexpr int PREP_PT_BYTES = 17408, PREP_WAVE_BYTES = 16128;
constexpr int STG_PITCH = 144;
constexpr int STG_BYTES = 33 * STG_PITCH;
constexpr int AIMG_PITCH = 36;

struct RwkvBufs { const bf16* rkv; const bf16* wdad2; bf16* mf; bf16* na; bf16* pf; bf16* qa; bf16* bv; const bf16* w2t; const bf16* a2t; };

__device__ __forceinline__ void stage_tile(LAS unsigned char* img, const bf16* src_row0  , int ldsrc, bool first, int lane) {
#pragma unroll
    for (int it = 0; it < 5; ++it) {
        const int q = lane + 64 * it;
        if (q < 264) { const int row = q >> 3, ch = q & 7;
            v4u v = {0u, 0u, 0u, 0u};
            if (!(first && row == 0)) v = *(const GAS v4u*)(src_row0 + (ptrdiff_t)(row - 1) * ldsrc + ch * 8);
            *(LAS v4u*)(img + row * STG_PITCH + ch * 16) = v; }
    }
}

__device__ __forceinline__ void rwkv_prep_unit(const RwkvBufs& B, int unit, LAS unsigned char* wl, const LAS float* pt, int lane_in) {
    int lane = lane_in; asm volatile("" : "+v"(lane));
    const int r = lane & 31, lh = lane >> 5;
    const int c = unit & 127, hd = (unit >> 7) & 7, b = unit >> 10;
    const size_t m0 = (size_t)b * SEQ + c * 32;
    LAS unsigned char* S0 = wl; LAS unsigned char* S1 = wl + STG_BYTES; LAS unsigned char* S2 = wl + 2 * STG_BYTES;
    LAS float* cumc = (LAS float*)(wl + 3 * STG_BYTES);
    LAS float* aimg = (LAS float*)wl;
    stage_tile(S0, B.rkv + m0 * 1536 + hd * 64, 1536, c == 0, lane);
    stage_tile(S1, B.rkv + m0 * 1536 + 512 + hd * 64, 1536, c == 0, lane);
    stage_tile(S2, B.rkv + m0 * 1536 + 1024 + hd * 64, 1536, c == 0, lane);
    f32x16 lwv[2], dav[2];
    {
        bf16x8_t tw[4], ad[4];
#pragma unroll
        for (int s = 0; s < 4; ++s) { tw[s] = *(const GAS bf16x8_t*)(B.wdad2 + (m0 + r) * 128 + 16 * s + 8 * lh); ad[s] = *(const GAS bf16x8_t*)(B.wdad2 + (m0 + r) * 128 + 64 + 16 * s + 8 * lh); }
#pragma unroll
        for (int mt = 0; mt < 2; ++mt) { f32x16 a1 = zero16(), a2 = zero16();
#pragma unroll
            for (int s = 0; s < 4; ++s) { const bf16x8_t wa = *(const GAS bf16x8_t*)(B.w2t + (size_t)(hd * 64 + 32 * mt + r) * 64 + 16 * s + 8 * lh);
                const bf16x8_t aa = *(const GAS bf16x8_t*)(B.a2t + (size_t)(hd * 64 + 32 * mt + r) * 64 + 16 * s + 8 * lh);
                a1 = MFMA32(wa, tw[s], a1); a2 = MFMA32(aa, ad[s], a2); }
            lwv[mt] = a1; dav[mt] = a2; }
    }
#pragma unroll
    for (int it = 0; it < 2; ++it)
#pragma unroll
        for (int g = 0; g < 4; ++g) { const f32x4 w0v = *(const LAS f32x4*)(pt + PT_W0 + hd * 64 + 32 * it + 8 * g + 4 * lh);
#pragma unroll
            for (int e = 0; e < 4; ++e) { const int i = 4 * g + e; const float x = -(w0v[e] + lwv[it][i]);
                const float sp = fmaxf(x, 0.f) + __logf(1.f + __expf(-fabsf(x)));
                lwv[it][i] = -__expf(-sp - 0.5f); } }
#pragma unroll
    for (int d = 1; d < 32; d <<= 1)
#pragma unroll
        for (int it = 0; it < 2; ++it)
#pragma unroll
            for (int i = 0; i < 16; ++i) { const float y = __shfl_up(lwv[it][i], d, 32); if (r >= d) lwv[it][i] += y; }
    if (r == 31) {
#pragma unroll
        for (int it = 0; it < 2; ++it)
#pragma unroll
            for (int g = 0; g < 4; ++g) { f32x4 v = {lwv[it][4 * g], lwv[it][4 * g + 1], lwv[it][4 * g + 2], lwv[it][4 * g + 3]}; *(LAS f32x4*)(cumc + 32 * it + 8 * g + 4 * lh) = v; }
    }
#pragma unroll
    for (int it = 0; it < 2; ++it)
#pragma unroll
        for (int i = 0; i < 16; ++i) lwv[it][i] = __expf(lwv[it][i]);
    asm volatile("" ::: "memory");
    float n2 = 0.f;
#pragma unroll
    for (int it = 0; it < 2; ++it)
#pragma unroll
        for (int g = 0; g < 4; ++g) { const int cl0 = 32 * it + 8 * g + 4 * lh;
            const u32x2_t kc = *(const LAS u32x2_t*)(S1 + (r + 1) * STG_PITCH + cl0 * 2), kp = *(const LAS u32x2_t*)(S1 + r * STG_PITCH + cl0 * 2);
            const f32x4 muk = *(const LAS f32x4*)(pt + PT_MU + 512 + hd * 64 + cl0), kkv = *(const LAS f32x4*)(pt + PT_KK + hd * 64 + cl0);
            const float k0 = bflo(kc.x), k1 = bfhi(kc.x), k2 = bflo(kc.y), k3 = bfhi(kc.y), p0 = bflo(kp.x), p1 = bfhi(kp.x), p2 = bflo(kp.y), p3 = bfhi(kp.y);
            const float a0 = (k0 + (p0 - k0) * muk[0]) * kkv[0], a1 = (k1 + (p1 - k1) * muk[1]) * kkv[1], a2 = (k2 + (p2 - k2) * muk[2]) * kkv[2], a3 = (k3 + (p3 - k3) * muk[3]) * kkv[3];
            n2 += (a0 * a0 + a1 * a1) + (a2 * a2 + a3 * a3); asm volatile("" ::: "memory"); }
    n2 += __shfl_xor(n2, 32);
    const float kinv = 1.f / fmaxf(sqrtf(n2), 1e-12f);
    P8 ACT[2], RCT[2], BCT[2], KCT[2];
    float bon = 0.f;
#pragma unroll
    for (int it = 0; it < 2; ++it)
#pragma unroll
        for (int g = 0; g < 4; ++g) { const int cl0 = 32 * it + 8 * g + 4 * lh, ch0 = hd * 64 + cl0;
            const u32x2_t rc = *(const LAS u32x2_t*)(S0 + (r + 1) * STG_PITCH + cl0 * 2), rp = *(const LAS u32x2_t*)(S0 + r * STG_PITCH + cl0 * 2);
            const u32x2_t kc = *(const LAS u32x2_t*)(S1 + (r + 1) * STG_PITCH + cl0 * 2), kp = *(const LAS u32x2_t*)(S1 + r * STG_PITCH + cl0 * 2);
            const f32x4 mur = *(const LAS f32x4*)(pt + PT_MU + ch0), muk = *(const LAS f32x4*)(pt + PT_MU + 512 + ch0);
            const f32x4 a0v = *(const LAS f32x4*)(pt + PT_A0 + ch0), kkv = *(const LAS f32x4*)(pt + PT_KK + ch0), kav = *(const LAS f32x4*)(pt + PT_KA + ch0), rkv = *(const LAS f32x4*)(pt + PT_RK + ch0);
            const float rr[4] = {bflo(rc.x), bfhi(rc.x), bflo(rc.y), bfhi(rc.y)}, rq[4] = {bflo(rp.x), bfhi(rp.x), bflo(rp.y), bfhi(rp.y)};
            const float kr[4] = {bflo(kc.x), bfhi(kc.x), bflo(kc.y), bfhi(kc.y)}, kq[4] = {bflo(kp.x), bfhi(kp.x), bflo(kp.y), bfhi(kp.y)};
            float oA[4], oR[4], oB[4], oK[4];
#pragma unroll
            for (int e = 0; e < 4; ++e) { const int i = 4 * g + e;
                const float rs = rr[e] + (rq[e] - rr[e]) * mur[e], ks = kr[e] + (kq[e] - kr[e]) * muk[e];
                const float aa = __builtin_amdgcn_rcpf(1.f + __expf(-(a0v[e] + dav[it][i])));
                const float kk = ks * kkv[e] * kinv;
                const float kpr = ks * (1.f + (aa - 1.f) * kav[e]);
                bon += rs * kpr * rkv[e];
                const float e2 = lwv[it][i]; float e1 = __shfl_up(e2, 1, 32); e1 = (r == 0) ? 1.f : e1;
                const float e3 = __builtin_amdgcn_rcpf(e2);
                oA[e] = -kk * e1; oR[e] = rs * e2; oB[e] = kk * aa * e3; oK[e] = kpr * e3; }
            ACT[it].w[2 * g] = cvtpk(oA[0], oA[1]); ACT[it].w[2 * g + 1] = cvtpk(oA[2], oA[3]);
            RCT[it].w[2 * g] = cvtpk(oR[0], oR[1]); RCT[it].w[2 * g + 1] = cvtpk(oR[2], oR[3]);
            BCT[it].w[2 * g] = cvtpk(oB[0], oB[1]); BCT[it].w[2 * g + 1] = cvtpk(oB[2], oB[3]);
            KCT[it].w[2 * g] = cvtpk(oK[0], oK[1]); KCT[it].w[2 * g + 1] = cvtpk(oK[2], oK[3]);
            asm volatile("" ::: "memory"); }
    bon += __shfl_xor(bon, 32);
    const float gam0 = __expf(cumc[r]), gam1 = __expf(cumc[32 + r]);
    LDS_WAIT(); asm volatile("" ::: "memory");
    { f32x16 acc = zero16(); acc = mm1(ACT[0], BCT[0], acc); acc = mm1(ACT[1], BCT[1], acc);
#pragma unroll
      for (int g = 0; g < 4; ++g) { f32x4 v;
#pragma unroll
          for (int e = 0; e < 4; ++e) v[e] = (8 * g + 4 * lh + e > r) ? acc[4 * g + e] : 0.f;
          *(LAS f32x4*)(aimg + r * AIMG_PITCH + 8 * g + 4 * lh) = v; } }
    float Tr[32];
#pragma unroll
    for (int j = 0; j < 32; ++j) Tr[j] = (j == r) ? 1.f : 0.f;
    LDS_WAIT(); asm volatile("" ::: "memory");
#pragma unroll
    for (int j = 30; j >= 0; --j) { float acc = 0.f;
#pragma unroll
        for (int q = (j + 1) >> 2; q < 8; ++q) { const f32x4 av = *(const LAS f32x4*)(aimg + j * AIMG_PITCH + 4 * q);
            acc += Tr[4 * q] * av[0] + Tr[4 * q + 1] * av[1] + Tr[4 * q + 2] * av[2] + Tr[4 * q + 3] * av[3]; }
        Tr[j] = (r > j) ? acc : Tr[j]; }
    P8 XT;
#pragma unroll
    for (int q = 0; q < 8; ++q) { const int i0 = 2 * q, i1 = 2 * q + 1;
        const float v0 = lh ? Tr[(i0 & 3) + 8 * (i0 >> 2) + 4] : Tr[(i0 & 3) + 8 * (i0 >> 2)], v1 = lh ? Tr[(i1 & 3) + 8 * (i1 >> 2) + 4] : Tr[(i1 & 3) + 8 * (i1 >> 2)];
        XT.w[q] = cvtpk(v0, v1); }
    P8 Aak, Arb, Ark;
    { f32x16 acc = zero16(); acc = mm1(KCT[0], ACT[0], acc); acc = mm1(KCT[1], ACT[1], acc);
#pragma unroll
      for (int i = 0; i < 16; ++i) acc[i] = ((i & 3) + 8 * (i >> 2) + 4 * lh < r) ? acc[i] : 0.f;
      Aak = pack_tile(acc); }
    { f32x16 acc = zero16(); acc = mm1(BCT[0], RCT[0], acc); acc = mm1(BCT[1], RCT[1], acc);
#pragma unroll
      for (int i = 0; i < 16; ++i) acc[i] = ((i & 3) + 8 * (i >> 2) + 4 * lh <= r) ? acc[i] : 0.f;
      Arb = pack_tile(acc); }
    { f32x16 acc = zero16(); acc = mm1(KCT[0], RCT[0], acc); acc = mm1(KCT[1], RCT[1], acc);
#pragma unroll
      for (int i = 0; i < 16; ++i) acc[i] = ((i & 3) + 8 * (i >> 2) + 4 * lh <= r) ? acc[i] : 0.f;
      Ark = pack_tile(acc); }
    P8 If;
#pragma unroll
    for (int q = 0; q < 8; ++q) { const int i0 = 2 * q, i1 = 2 * q + 1;
        const unsigned lo = ((i0 & 3) + 8 * (i0 >> 2) + 4 * lh == r) ? 0x3f80u : 0u, hi = ((i1 & 3) + 8 * (i1 >> 2) + 4 * lh == r) ? 0x3f800000u : 0u; If.w[q] = lo | hi; }
    P8 VC[2], AC[2], BhC[2], KhC[2];
#pragma unroll
    for (int ct = 0; ct < 2; ++ct) {
        AC[ct] = pack_tile(mm1(ACT[ct], If, zero16()));
        P8 VCT; f32x16 bvv;
#pragma unroll
        for (int g = 0; g < 4; ++g) { const int cl0 = 32 * ct + 8 * g + 4 * lh;
            const u32x2_t vc = *(const LAS u32x2_t*)(S2 + (r + 1) * STG_PITCH + cl0 * 2), vp = *(const LAS u32x2_t*)(S2 + r * STG_PITCH + cl0 * 2);
            const f32x4 muv = *(const LAS f32x4*)(pt + PT_MU + 1024 + hd * 64 + cl0);
            const float v0 = bflo(vc.x), v1 = bfhi(vc.x), v2 = bflo(vc.y), v3 = bfhi(vc.y), q0 = bflo(vp.x), q1 = bfhi(vp.x), q2 = bflo(vp.y), q3 = bfhi(vp.y);
            const float s0 = v0 + (q0 - v0) * muv[0], s1 = v1 + (q1 - v1) * muv[1], s2 = v2 + (q2 - v2) * muv[2], s3 = v3 + (q3 - v3) * muv[3];
            VCT.w[2 * g] = cvtpk(s0, s1); VCT.w[2 * g + 1] = cvtpk(s2, s3);
            bvv[4 * g] = s0 * bon; bvv[4 * g + 1] = s1 * bon; bvv[4 * g + 2] = s2 * bon; bvv[4 * g + 3] = s3 * bon; }
        { const P8 p = pack_tile(bvv); GAS u32x4_t* dst = (GAS u32x4_t*)(B.bv + (size_t)unit * (RW_BV_BYTES / 2) + (size_t)(ct * 64 + lane) * 16);
          dst[0] = (u32x4_t){p.w[0], p.w[1], p.w[2], p.w[3]}; dst[1] = (u32x4_t){p.w[4], p.w[5], p.w[6], p.w[7]}; }
        VC[ct] = pack_tile(mm1(VCT, If, zero16()));
        f32x16 bh = unpack_tile(BCT[ct]), kh = unpack_tile(KCT[ct]);
#pragma unroll
        for (int g = 0; g < 4; ++g) { const f32x4 cc = *(const LAS f32x4*)(cumc + 32 * ct + 8 * g + 4 * lh);
#pragma unroll
            for (int e = 0; e < 4; ++e) { const float gm = __expf(cc[e]); bh[4 * g + e] *= gm; kh[4 * g + e] *= gm; } }
        BhC[ct] = pack_tile(mm1(pack_tile(bh), If, zero16())); KhC[ct] = pack_tile(mm1(pack_tile(kh), If, zero16()));
        asm volatile("" ::: "memory"); }
    P8 UC[2], WC[2];
#pragma unroll
    for (int ct = 0; ct < 2; ++ct) { const P8 X1 = pack_tile(mm1(Aak, VC[ct], zero16())); UC[ct] = pack_tile(mm1(XT, X1, zero16())); WC[ct] = pack_tile(mm1(XT, AC[ct], zero16())); }
    { bf16* mfp = B.mf + (size_t)unit * (RW_MF_BYTES / 2);
#pragma unroll
      for (int cpt = 0; cpt < 2; ++cpt)
#pragma unroll
          for (int ct = 0; ct < 2; ++ct) { f32x16 acc = mm1(WC[cpt], BhC[ct], zero16());
              if (cpt == ct) { const float gm = ct ? gam1 : gam0;
#pragma unroll
                  for (int i = 0; i < 16; ++i) acc[i] += ((i & 3) + 8 * (i >> 2) + 4 * lh == r) ? gm : 0.f; }
              const P8 p = pack_tile(acc);
              *(GAS u32x4_t*)(mfp + (size_t)(((ct * 2 + cpt) * 2 + 0) * 64 + lane) * 8) = (u32x4_t){p.w[0], p.w[1], p.w[2], p.w[3]};
              *(GAS u32x4_t*)(mfp + (size_t)(((ct * 2 + cpt) * 2 + 1) * 64 + lane) * 8) = (u32x4_t){p.w[4], p.w[5], p.w[6], p.w[7]}; } }
    { bf16* nap = B.na + (size_t)unit * (RW_NA_BYTES / 2);
#pragma unroll
      for (int ct = 0; ct < 2; ++ct)
#pragma unroll
          for (int vt = 0; vt < 2; ++vt) { f32x16 acc = mm1(BhC[ct], UC[vt], zero16()); acc = mm1(KhC[ct], VC[vt], acc);
              const P8 p = pack_tile(acc); GAS u32x4_t* dst = (GAS u32x4_t*)(nap + (size_t)((ct * 2 + vt) * 64 + lane) * 16);
              dst[0] = (u32x4_t){p.w[0], p.w[1], p.w[2], p.w[3]}; dst[1] = (u32x4_t){p.w[4], p.w[5], p.w[6], p.w[7]}; } }
    { bf16* pfp = B.pf + (size_t)unit * (RW_PF_BYTES / 2);
#pragma unroll
      for (int ct = 0; ct < 2; ++ct) { f32x16 acc = mm1(WC[ct], Arb, unpack_tile(RCT[ct]));
          const P8 p = pack_tile(acc);
          *(GAS u32x4_t*)(pfp + (size_t)((ct * 2 + 0) * 64 + lane) * 8) = (u32x4_t){p.w[0], p.w[1], p.w[2], p.w[3]};
          *(GAS u32x4_t*)(pfp + (size_t)((ct * 2 + 1) * 64 + lane) * 8) = (u32x4_t){p.w[4], p.w[5], p.w[6], p.w[7]}; } }
    { bf16* qap = B.qa + (size_t)unit * (RW_QA_BYTES / 2);
#pragma unroll
      for (int vt = 0; vt < 2; ++vt) { f32x16 acc = mm1(UC[vt], Arb, zero16()); acc = mm1(VC[vt], Ark, acc);
          const P8 p = pack_tile(acc); GAS u32x4_t* dst = (GAS u32x4_t*)(qap + (size_t)(vt * 64 + lane) * 16);
          dst[0] = (u32x4_t){p.w[0], p.w[1], p.w[2], p.w[3]}; dst[1] = (u32x4_t){p.w[4], p.w[5], p.w[6], p.w[7]}; } }
    LDS_WAIT(); asm volatile("" ::: "memory");
}

struct SeqIn { u32x4_t mf[8]; u32x4_t na[2][2]; u32x4_t pf[4]; u32x4_t qa[2]; };
__device__ __forceinline__ void seq_load(SeqIn& s, const RwkvBufs& B, int unit, int vt, int lane) {
    const bf16* mfp = B.mf + (size_t)unit * (RW_MF_BYTES / 2);
#pragma unroll
    for (int f = 0; f < 8; ++f) s.mf[f] = *(const GAS u32x4_t*)(mfp + (size_t)(f * 64 + lane) * 8);
    const bf16* nap = B.na + (size_t)unit * (RW_NA_BYTES / 2);
#pragma unroll
    for (int ct = 0; ct < 2; ++ct) { const GAS u32x4_t* p = (const GAS u32x4_t*)(nap + (size_t)((ct * 2 + vt) * 64 + lane) * 16); s.na[ct][0] = p[0]; s.na[ct][1] = p[1]; }
    const bf16* pfp = B.pf + (size_t)unit * (RW_PF_BYTES / 2);
#pragma unroll
    for (int f = 0; f < 4; ++f) s.pf[f] = *(const GAS u32x4_t*)(pfp + (size_t)(f * 64 + lane) * 8);
    const GAS u32x4_t* q = (const GAS u32x4_t*)(B.qa + (size_t)unit * (RW_QA_BYTES / 2) + (size_t)(vt * 64 + lane) * 16); s.qa[0] = q[0]; s.qa[1] = q[1];
}
__device__ __forceinline__ f32x16 unpack2(const u32x4_t& a, const u32x4_t& b) { P8 p; p.w[0] = a[0]; p.w[1] = a[1]; p.w[2] = a[2]; p.w[3] = a[3]; p.w[4] = b[0]; p.w[5] = b[1]; p.w[6] = b[2]; p.w[7] = b[3]; return unpack_tile(p); }
__device__ __forceinline__ void rwkv_seq_wave(const RwkvBufs& B, int bh, int vt, int lane) {
    f32x16 H[2] = {zero16(), zero16()};
    SeqIn cur, nxt;
    seq_load(cur, B, bh * 128, vt, lane);
    for (int c = 0; c < 128; ++c) {
        const int unit = bh * 128 + c;
        if (c + 1 < 128) seq_load(nxt, B, unit + 1, vt, lane);
        const P8 HP0 = pack_tile(H[0]), HP1 = pack_tile(H[1]);
        f32x16 yt = unpack2(cur.qa[0], cur.qa[1]);
        yt = MFMA32(frag<0>(HP0), __builtin_bit_cast(bf16x8_t, cur.pf[0]), yt); yt = MFMA32(frag<1>(HP0), __builtin_bit_cast(bf16x8_t, cur.pf[1]), yt);
        yt = MFMA32(frag<0>(HP1), __builtin_bit_cast(bf16x8_t, cur.pf[2]), yt); yt = MFMA32(frag<1>(HP1), __builtin_bit_cast(bf16x8_t, cur.pf[3]), yt);
        f32x16 hn[2];
#pragma unroll
        for (int ct = 0; ct < 2; ++ct) { f32x16 acc = unpack2(cur.na[ct][0], cur.na[ct][1]);
            acc = MFMA32(__builtin_bit_cast(bf16x8_t, cur.mf[(ct * 2 + 0) * 2 + 0]), frag<0>(HP0), acc); acc = MFMA32(__builtin_bit_cast(bf16x8_t, cur.mf[(ct * 2 + 0) * 2 + 1]), frag<1>(HP0), acc);
            acc = MFMA32(__builtin_bit_cast(bf16x8_t, cur.mf[(ct * 2 + 1) * 2 + 0]), frag<0>(HP1), acc); acc = MFMA32(__builtin_bit_cast(bf16x8_t, cur.mf[(ct * 2 + 1) * 2 + 1]), frag<1>(HP1), acc);
            hn[ct] = acc; }
        H[0] = hn[0]; H[1] = hn[1];
        const P8 yp = pack_tile(yt);
        GAS u32x4_t* q = (GAS u32x4_t*)(B.qa + (size_t)unit * (RW_QA_BYTES / 2) + (size_t)(vt * 64 + lane) * 16);
        q[0] = (u32x4_t){yp.w[0], yp.w[1], yp.w[2], yp.w[3]}; q[1] = (u32x4_t){yp.w[4], yp.w[5], yp.w[6], yp.w[7]};
        cur = nxt;
    }
}

__device__ __forceinline__ void rwkv_post_unit(const RwkvBufs& B, const bf16* gates, const float* lnw, const float* lnb, bf16* ybuf, int unit, int lane) {
    const int r = lane & 31, lh = lane >> 5;
    const int c = unit & 127, hd = (unit >> 7) & 7, b = unit >> 10;
    const size_t m = (size_t)b * SEQ + c * 32 + r;
    f32x16 y[2], bvv[2];
#pragma unroll
    for (int vt = 0; vt < 2; ++vt) { const GAS u32x4_t* q = (const GAS u32x4_t*)(B.qa + (size_t)unit * (RW_QA_BYTES / 2) + (size_t)(vt * 64 + lane) * 16); const u32x4_t q0 = q[0], q1 = q[1]; y[vt] = unpack2(q0, q1);
        const GAS u32x4_t* p = (const GAS u32x4_t*)(B.bv + (size_t)unit * (RW_BV_BYTES / 2) + (size_t)(vt * 64 + lane) * 16); const u32x4_t p0 = p[0], p1 = p[1]; bvv[vt] = unpack2(p0, p1); }
    float s = 0.f;
#pragma unroll
    for (int vt = 0; vt < 2; ++vt)
#pragma unroll
        for (int i = 0; i < 16; ++i) s += y[vt][i];
    s += __shfl_xor(s, 32); const float mean = s * (1.f / 64.f);
    float q2 = 0.f;
#pragma unroll
    for (int vt = 0; vt < 2; ++vt)
#pragma unroll
        for (int i = 0; i < 16; ++i) { const float d = y[vt][i] - mean; q2 += d * d; }
    q2 += __shfl_xor(q2, 32); const float rstd = 1.f / sqrtf(q2 * (1.f / 64.f) + GN_EPS);
#pragma unroll
    for (int vt = 0; vt < 2; ++vt)
#pragma unroll
        for (int g = 0; g < 4; ++g) { const int ch0 = hd * 64 + 32 * vt + 8 * g + 4 * lh;
            const f32x4 lw = *(const GAS f32x4*)(lnw + ch0), lb = *(const GAS f32x4*)(lnb + ch0);
            const u32x2_t gt = *(const GAS u32x2_t*)(gates + m * 1024 + ch0);
            const float gg[4] = {bflo(gt.x), bfhi(gt.x), bflo(gt.y), bfhi(gt.y)}; float o[4];
#pragma unroll
            for (int e = 0; e < 4; ++e) { const int i = 4 * g + e; const float v = (y[vt][i] - mean) * rstd * lw[e] + lb[e] + bvv[vt][i]; o[e] = v * gg[e] * __builtin_amdgcn_rcpf(1.f + __expf(-gg[e])); }
            u32x2_t w; w.x = cvtpk(o[0], o[1]); w.y = cvtpk(o[2], o[3]);
            *(GAS u32x2_t*)(ybuf + m * DM + ch0) = w; }
}

__device__ __forceinline__ void phase_wdad(const Args& a, int tid) {
    const bf16* src = (const bf16*)(a.ws + WS_WDAD); bf16* dst = (bf16*)(a.ws + WS_WDAD2); const float* mu = a.in[3] + 1536;
    for (int it = blockIdx.x * 512 + tid; it < MTOK * 16; it += gridDim.x * 512) {
        const int m = it >> 4, ch = it & 15, t = m % SEQ;
        const v4u cv = *(const GAS v4u*)(src + (size_t)m * 128 + ch * 8); v4u pv = {0u, 0u, 0u, 0u};
        if (t > 0) pv = *(const GAS v4u*)(src + (size_t)(m - 1) * 128 + ch * 8);
        const f32x4 m0 = *(const GAS f32x4*)(mu + ch * 8), m1 = *(const GAS f32x4*)(mu + ch * 8 + 4);
        float o[8];
#pragma unroll
        for (int q = 0; q < 4; ++q) { const unsigned cw = cv[q], pw = pv[q];
            const float c0 = bflo(cw), c1 = bfhi(cw), p0 = bflo(pw), p1 = bfhi(pw);
            const float ma = (q < 2) ? m0[2 * q] : m1[2 * q - 4], mb = (q < 2) ? m0[2 * q + 1] : m1[2 * q - 3];
            o[2 * q] = c0 + (p0 - c0) * ma; o[2 * q + 1] = c1 + (p1 - c1) * mb; }
        if (ch < 8) {
#pragma unroll
            for (int q = 0; q < 8; ++q) o[q] = 1.f - 2.f * __builtin_amdgcn_rcpf(1.f + __expf(2.f * o[q]));
        }
        v4u ov = {cvtpk(o[0], o[1]), cvtpk(o[2], o[3]), cvtpk(o[4], o[5]), cvtpk(o[6], o[7])};
        *(GAS v4u*)(dst + (size_t)m * 128 + ch * 8) = ov;
    }
}

struct EpiSplit {
    static constexpr bool PERM = true, AFTER_DRAIN = false;
    bf16 *rkv, *qkva, *gates, *wdad;
    __device__ __forceinline__ void operator()(const pg8::f32x4 (&acc)[2][2][4][2], const pg8::Unit& u, int wr, int wc, int fr, int fq) const {
        const int pn = u.pn; bf16* base; int ldc, colt;
        if (pn < 6) { base = rkv; ldc = 1536; colt = pn * 256; } else if (pn < 12) { base = qkva; ldc = 1536; colt = (pn - 6) * 256; }
        else if (pn < 16) { base = gates; ldc = 1024; colt = (pn - 12) * 256; } else { base = wdad; ldc = 128; colt = 0; }
        const int row0 = u.pm * pg8::BM + wr * 64 + fr, col0 = colt + wc * 32 + 8 * fq;
#pragma unroll
        for (int ai = 0; ai < 2; ++ai)
#pragma unroll
            for (int m = 0; m < 4; ++m) { bf16* rowp = base + (size_t)(row0 + ai * pg8::HALF + m * 16) * ldc + col0;
#pragma unroll
                for (int bj = 0; bj < 2; ++bj) { if (pn == 16 && bj == 1) continue;
                    const pg8::f32x4 v0 = acc[ai][bj][m][0], v1 = acc[ai][bj][m][1];
                    pg8::u32x4 w; w.x = pg8::cvt_pk_bf16(v0[0], v0[1]); w.y = pg8::cvt_pk_bf16(v0[2], v0[3]); w.z = pg8::cvt_pk_bf16(v1[0], v1[1]); w.w = pg8::cvt_pk_bf16(v1[2], v1[3]);
                    *(pg8::u32x4*)(rowp + bj * pg8::HALF) = w; } }
    }
};
__global__ void __launch_bounds__(NWAVES * 64, 2) k_fused(Args a) {
    extern __shared__ __attribute__((aligned(16))) unsigned char lds_raw[];
    LAS unsigned char* lds = (LAS unsigned char*)lds_raw;
    volatile LAS unsigned* MISC = (volatile LAS unsigned*)(lds + MISC_OFF);
    const int tid = threadIdx.x, lane = tid & 63, wave = __builtin_amdgcn_readfirstlane(tid >> 6);
    gu32* ctl = (gu32*)(a.ws + WS_CTL);
    for (int u = tid; u < (LDS_BYTES - LDSCTL_OFF) / 4; u += NWAVES * 64) ((LAS unsigned*)(lds + LDSCTL_OFF))[u] = 0u;
    __syncthreads();
    XcdBarrier bar = xcd_barrier_post((unsigned*)(ctl + CW_BAR), MISC + 8);

    phase_prologue(a, lds, tid, lane, wave);
    xcd_barrier(bar);
    {
        pg8::Gemm g{(const pg8::bf16_t*)(a.ws + WS_XN), (const pg8::bf16_t*)(a.ws + WS_WIN), MTOK, NPROJ_PAD, DM};
        pg8::StaticOrder S; S.init(MTOK, NPROJ_PAD, gridDim.x, (int)blockIdx.x);
        EpiSplit E{(bf16*)(a.ws + WS_RKV), (bf16*)(a.ws + WS_QKVA), (bf16*)(a.ws + WS_GATES), (bf16*)(a.ws + WS_WDAD)};
        pg8::gemm_phase<EpiSplit, pg8::StaticOrder, true, true>(lds + RING_OFF, g, S, E);
    }
    xcd_barrier(bar);
    phase_kmean(a, tid);
    phase_wdad(a, tid);
    xcd_barrier(bar);
    RwkvBufs RB{(const bf16*)(a.ws + WS_RKV), (const bf16*)(a.ws + WS_WDAD2), (bf16*)(a.ws + WS_MF), (bf16*)(a.ws + WS_NA), (bf16*)(a.ws + WS_PF), (bf16*)(a.ws + WS_QA), (bf16*)(a.ws + WS_BV),
                (const bf16*)(a.ws + WS_W2T), (const bf16*)(a.ws + WS_A2T)};
    {
        LAS float* pt = (LAS float*)(lds + RING_OFF);
        for (int i = tid; i < PT_FLOATS; i += NWAVES * 64) { float v;
            if (i < PT_W0) v = a.in[3][i]; else if (i < PT_A0) v = a.in[4][i - PT_W0]; else if (i < PT_KK) v = a.in[6][i - PT_A0]; else if (i < PT_KA) v = a.in[8][i - PT_KK];
            else if (i < PT_RK) v = a.in[9][i - PT_KA]; else v = a.in[10][i - PT_RK];
            pt[i] = v; }
        __syncthreads();
        LAS unsigned char* wl = lds + RING_OFF + PREP_PT_BYTES + wave * PREP_WAVE_BYTES;
        for (int u = blockIdx.x * NWAVES + wave; u < RW_NUNITS; u += gridDim.x * NWAVES) rwkv_prep_unit(RB, u, wl, pt, lane);
    }
    xcd_barrier(bar);
    {
        if (blockIdx.x < 2 * BATCH * NH && wave == 0) rwkv_seq_wave(RB, blockIdx.x >> 1, blockIdx.x & 1, lane);
        LAS float* scr = (LAS float*)(lds + RING_OFF + 65536 + wave * 8192);
        constexpr int NITEMS = MTOK * NH, CH = 32;
        for (;;) {
            unsigned base = 0;
            if (lane == 0) base = __hip_atomic_fetch_add((unsigned*)(ctl + CW_QUEUE), (unsigned)CH, __ATOMIC_RELAXED, __HIP_MEMORY_SCOPE_AGENT);
            base = (unsigned)__builtin_amdgcn_readfirstlane((int)base);
            if (base >= (unsigned)NITEMS) break;
            for (int i = 0; i < CH; ++i) moba_simple_item(a, (int)base + i, scr, lane);
        }
    }
    xcd_barrier(bar);
    for (int u = blockIdx.x * NWAVES + wave; u < RW_NUNITS; u += gridDim.x * NWAVES)
        rwkv_post_unit(RB, (const bf16*)(a.ws + WS_GATES), a.in[11], a.in[12], (bf16*)(a.ws + WS_YBUF), u, lane);
    xcd_barrier(bar);
    {
        pg8::Gemm g{(const pg8::bf16_t*)(a.ws + WS_YBUF), (const pg8::bf16_t*)(a.ws + WS_WOUT), MTOK, DM, DM};
        pg8::StaticOrder S; S.init(MTOK, DM, gridDim.x, (int)blockIdx.x);
        pg8::EpiF32 E{(float*)(a.ws + WS_OBUF), DM, nullptr};
        pg8::gemm_phase<pg8::EpiF32, pg8::StaticOrder, true, true>(lds + RING_OFF, g, S, E);
    }
    xcd_barrier(bar);
    phase_final(a, lane, wave);
}

extern "C" void kernel_launch(void* const* d_in, const int* in_sizes, int n_in, void* d_out, int out_size, void* d_ws, size_t ws_size, hipStream_t stream) {
    static int grid = 0;
    if (grid == 0) {
        if (n_in != 15 || in_sizes[0] != MTOK * DM || out_size != MTOK * DM || ws_size < WS_END) { fprintf(stderr, "kernel_launch: bad shapes n_in %d in0 %d out %d ws %zu\n", n_in, n_in > 0 ? in_sizes[0] : -1, out_size, ws_size); grid = -1; return; }
        int dev = 0, cus = 0, per_cu = 0;
        if (hipGetDevice(&dev) != hipSuccess || hipDeviceGetAttribute(&cus, hipDeviceAttributeMultiprocessorCount, dev) != hipSuccess) { grid = -1; return; }
        if (hipFuncSetAttribute((const void*)k_fused, hipFuncAttributeMaxDynamicSharedMemorySize, LDS_BYTES) != hipSuccess) { grid = -1; return; }
        if (hipOccupancyMaxActiveBlocksPerMultiprocessor(&per_cu, (const void*)k_fused, NWAVES * 64, LDS_BYTES) != hipSuccess || per_cu < 1) { fprintf(stderr, "kernel_launch: occupancy query says %d\n", per_cu); }
        (void)hipGetLastError();
        grid = cus;
    }
    if (grid < 0) return;
    if (hipMemsetAsync((char*)d_ws + WS_CTL, 0, CTL_ZERO_BYTES, stream) != hipSuccess) return;
    Args a{};
    for (int i = 0; i < 15; ++i) a.in[i] = (const float*)d_in[i];
    a.out = (float*)d_out; a.ws = (unsigned char*)d_ws;
    hipLaunchKernelGGL(k_fused, dim3(grid), dim3(NWAVES * 64), LDS_BYTES, stream, a);
}
```

```cpp
#include <hip/hip_runtime.h>
#include <cstdio>
#include <cstdint>
#include <cmath>
namespace pg8 {
#define PG8_LAS __attribute__((address_space(3)))
typedef unsigned short bf16_t;
typedef short bf16x8 __attribute__((ext_vector_type(8)));
typedef float f32x4 __attribute__((ext_vector_type(4)));
typedef unsigned u32x4 __attribute__((ext_vector_type(4)));
constexpr int BM = 256, BK = 64, HALF = 128, HTB = HALF * BK * 2  , STAGE_BYTES = 8 * HTB, NXCD = 8, WGM = 8;

__host__ __device__ __forceinline__ int lds_byte(int r, int c) { const int st = (r >> 4) * 2 + (c >> 5), rr = r & 15, cc = c & 31, ob = rr * 64 + cc * 2; return st * 1024 + (ob ^ (((ob >> 9) & 1) << 5)); }
__host__ __device__ __forceinline__ void stage_rc(int b, int& R, int& C) { const int st = b / 1024, sb = b % 1024, swz = sb ^ (((sb >> 9) & 1) << 5); R = (st >> 1) * 16 + swz / 64; C = (st & 1) * 32 + (swz % 64) / 2; }
__host__ __device__ __forceinline__ int perm32(int rho) { const int n = rho >> 4, i = rho & 15; return 8 * (i >> 2) + 4 * n + (i & 3); }

struct Unit { int pm, pn; };
struct Gemm { const bf16_t* A; const bf16_t* Bt; int M, N, K; };

struct StaticOrder {
    int nM, nN, nwg, G, c;
    __host__ __device__ void init(int M, int N, int G_, int c_) { nM = M / BM; nN = N / BM; nwg = nM * nN; G = G_; c = c_; }
    __host__ __device__ bool next(int i, Unit& u) const {
        const long L = (long)i * G + c; if (L >= nwg) return false;
        int wgid = (int)L; { const int q = nwg / NXCD, r = nwg % NXCD, xcd = wgid % NXCD, off = wgid / NXCD; wgid = (xcd < r ? xcd * (q + 1) : r * (q + 1) + (xcd - r) * q) + off; }
        const int nig = WGM * nN, gid = wgid / nig, fm = gid * WGM, gsz = (nM - fm) < WGM ? (nM - fm) : WGM;
        u.pm = fm + ((wgid % nig) % gsz); u.pn = (wgid % nig) / gsz; return true;
    }
    __device__ __forceinline__ void a_ready(const Unit&) const {}
    __device__ __forceinline__ void done(const Unit&) const {}
};

__device__ __forceinline__ unsigned cvt_pk_bf16(float lo, float hi) { unsigned r; asm volatile("v_cvt_pk_bf16_f32 %0, %1, %2" : "=v"(r) : "v"(lo), "v"(hi)); return r; }
typedef float f32x2 __attribute__((ext_vector_type(2)));
__device__ __forceinline__ f32x2 gelu_pk(f32x2 v) {
    const f32x2 av = __builtin_elementwise_abs(v), d = av * 0.2316418882f + 1.0f;
    f32x2 t; t.x = __builtin_amdgcn_rcpf(d.x); t.y = __builtin_amdgcn_rcpf(d.y);
    f32x2 q = t * 0.5307027145f + (-0.7265760135f); q = q * t + 0.7107068705f; q = q * t + (-0.142248368f); q = q * t + 0.127414796f; q = q * t;
    const f32x2 s = (v * v) * (-0.72134752044f);
    f32x2 e; e.x = __builtin_amdgcn_exp2f(s.x); e.y = __builtin_amdgcn_exp2f(s.y);
    const f32x2 m = v * (q * e), r = v - m;
    f32x2 o; o.x = v.x < 0.f ? m.x : r.x; o.y = v.y < 0.f ? m.y : r.y; return o;
}

template <int ACT  > struct EpiBf16 {
    static constexpr bool PERM = true, AFTER_DRAIN = false; static_assert(ACT == 0 || ACT == 1, "EpiBf16: ACT is 0 (none) or 1 (gelu_pk)");
    bf16_t* O; int ldc; const float* bias; int split_cols; size_t split_stride; float scale0;
    __device__ __forceinline__ void operator()(const f32x4 (&acc)[2][2][4][2], const Unit& u, int wr, int wc, int fr, int fq) const {
        const int row0 = u.pm * BM + wr * 64 + fr; int colt = u.pn * BM; bf16_t* base = O;
        float sc = 1.f; if (split_cols) { const int t = colt / split_cols; base += (size_t)t * split_stride; colt -= t * split_cols; if (t == 0) sc = scale0; }
        const int col0 = colt + wc * 32 + 8 * fq, bcol0 = u.pn * BM + wc * 32 + 8 * fq;
        f32x4 bv[2][2];
#pragma unroll
        for (int bj = 0; bj < 2; ++bj)
#pragma unroll
            for (int n = 0; n < 2; ++n) bv[bj][n] = bias ? *(const f32x4*)(bias + bcol0 + bj * HALF + 4 * n) : (f32x4){0.f, 0.f, 0.f, 0.f};
#pragma unroll
        for (int ai = 0; ai < 2; ++ai)
#pragma unroll
            for (int m = 0; m < 4; ++m) { bf16_t* rowp = base + (size_t)(row0 + ai * HALF + m * 16) * ldc + col0;
#pragma unroll
                for (int bj = 0; bj < 2; ++bj) { f32x4 v0 = acc[ai][bj][m][0] + bv[bj][0], v1 = acc[ai][bj][m][1] + bv[bj][1];
                    if (ACT == 1) { f32x2 a = gelu_pk((f32x2){v0[0], v0[1]}), b = gelu_pk((f32x2){v0[2], v0[3]}), c = gelu_pk((f32x2){v1[0], v1[1]}), d = gelu_pk((f32x2){v1[2], v1[3]});
                        v0 = (f32x4){a.x, a.y, b.x, b.y}; v1 = (f32x4){c.x, c.y, d.x, d.y}; }
                    v0 = v0 * sc; v1 = v1 * sc; u32x4 w; w.x = cvt_pk_bf16(v0[0], v0[1]); w.y = cvt_pk_bf16(v0[2], v0[3]); w.z = cvt_pk_bf16(v1[0], v1[1]); w.w = cvt_pk_bf16(v1[2], v1[3]);
                    *(u32x4*)(rowp + bj * HALF) = w; } }
    }
};

struct EpiF32 {
    static constexpr bool PERM = false, AFTER_DRAIN = false;
    float* C; int ldc; const float* bias;
    __device__ __forceinline__ void operator()(const f32x4 (&acc)[2][2][4][2], const Unit& u, int wr, int wc, int fr, int fq) const {
        const int row0 = u.pm * BM + wr * 64 + fr, col0 = u.pn * BM + wc * 32 + 4 * fq;
        f32x4 bv[2][2];
#pragma unroll
        for (int bj = 0; bj < 2; ++bj)
#pragma unroll
            for (int n = 0; n < 2; ++n) bv[bj][n] = bias ? *(const f32x4*)(bias + col0 + bj * HALF + n * 16) : (f32x4){0.f, 0.f, 0.f, 0.f};
#pragma unroll
        for (int ai = 0; ai < 2; ++ai)
#pragma unroll
            for (int m = 0; m < 4; ++m) { float* rowp = C + (size_t)(row0 + ai * HALF + m * 16) * ldc + col0;
#pragma unroll
                for (int bj = 0; bj < 2; ++bj)
#pragma unroll
                    for (int n = 0; n < 2; ++n) *(f32x4*)(rowp + bj * HALF + n * 16) = acc[ai][bj][m][n] + bv[bj][n]; }
    }
};

struct PanelStats {
    unsigned* xbuf;
    unsigned* cnt;
    unsigned* tmo;
    int ntn; float eps;
    unsigned code;
    __device__ __forceinline__ bool run(const f32x4 (&v)[2][2][4][2], const Unit& u, int wr, int wc, int fr, int fq, PG8_LAS unsigned char* lds, int wid, int lane) const {
        typedef float f32x2v __attribute__((ext_vector_type(2)));
        PG8_LAS f32x2v* P = (PG8_LAS f32x2v*)lds;
        PG8_LAS f32x2v* S = (PG8_LAS f32x2v*)(lds + 8192);
        PG8_LAS unsigned* flag = (PG8_LAS unsigned*)(lds + 8192 + 2048);
#pragma unroll
        for (int ai = 0; ai < 2; ++ai)
#pragma unroll
            for (int m = 0; m < 4; ++m) {
                float s = 0.f;
#pragma unroll
                for (int bj = 0; bj < 2; ++bj)
#pragma unroll
                    for (int n = 0; n < 2; ++n) { const f32x4 x = v[ai][bj][m][n]; s += (x[0] + x[1]) + (x[2] + x[3]); }
                s += __shfl_xor(s, 16); s += __shfl_xor(s, 32);
                const float mw = s * (1.0f / 64.0f); float q = 0.f;
#pragma unroll
                for (int bj = 0; bj < 2; ++bj)
#pragma unroll
                    for (int n = 0; n < 2; ++n) { const f32x4 d = v[ai][bj][m][n] - mw; q += (d[0] * d[0] + d[1] * d[1]) + (d[2] * d[2] + d[3] * d[3]); }
                q += __shfl_xor(q, 16); q += __shfl_xor(q, 32);
                if (fq == 0) P[(ai * HALF + wr * 64 + m * 16 + fr) * 4 + wc] = (f32x2v){mw, q};
            }
        asm volatile("s_waitcnt lgkmcnt(0)" ::: "memory"); __builtin_amdgcn_s_barrier(); asm volatile("" ::: "memory");
#if defined(BROKEN_EXCHANGE_NO_WAIT)
#warning BROKEN CONTROL BUILD: the row-statistics exchange does not wait; results are wrong by design
        if (blockIdx.x >= 64) { const long long t0_ = clock64(); while (clock64() - t0_ < 60000) __builtin_amdgcn_s_sleep(8); }
#endif
        const int row = wid * 32 + (lane & 31);
        if (lane < 32) {
            const f32x2v a = P[row * 4 + 0], b = P[row * 4 + 1], c = P[row * 4 + 2], d = P[row * 4 + 3];
            const float mt = (a.x + b.x + c.x + d.x) * 0.25f;
            const float da = a.x - mt, db = b.x - mt, dc = c.x - mt, dd = d.x - mt;
            const float m2 = (a.y + b.y) + (c.y + d.y) + 64.0f * ((da * da + db * db) + (dc * dc + dd * dd));
            unsigned long long* slot = (unsigned long long*)xbuf + ((size_t)(u.pm * BM + row) * 4 + u.pn);
            __hip_atomic_store(slot, ((unsigned long long)__float_as_uint(m2) << 32) | __float_as_uint(mt), __ATOMIC_RELAXED, __HIP_MEMORY_SCOPE_AGENT);
        }
        asm volatile("s_waitcnt vmcnt(0)" ::: "memory");
        if (lane == 0) __hip_atomic_fetch_add(cnt + 64 * u.pm, 1u, __ATOMIC_RELAXED, __HIP_MEMORY_SCOPE_AGENT);
        if (wid == 0) {
            bool dead = false; const unsigned long long t0 = __builtin_amdgcn_s_memrealtime(); const unsigned want = 8u * (unsigned)ntn;
            for (;;) {
#if defined(BROKEN_EXCHANGE_NO_WAIT)
                break;
#endif
                if ((unsigned)__builtin_amdgcn_readfirstlane(__hip_atomic_load(cnt + 64 * u.pm, __ATOMIC_RELAXED, __HIP_MEMORY_SCOPE_AGENT)) >= want) break;
                if (__builtin_amdgcn_s_memrealtime() - t0 > 2000000ull) {
                    if (lane == 0) { unsigned expect = 0u; __hip_atomic_compare_exchange_strong(tmo + 1, &expect, code | (unsigned)(u.pm & 0xff), __ATOMIC_RELAXED, __ATOMIC_RELAXED, __HIP_MEMORY_SCOPE_AGENT);
                                     __hip_atomic_store(tmo, 1u, __ATOMIC_RELAXED, __HIP_MEMORY_SCOPE_AGENT); }
                    dead = true; break; }
                __builtin_amdgcn_s_sleep(2);
            }
            __builtin_amdgcn_fence(__ATOMIC_ACQUIRE, "agent");
            if (lane == 0) flag[0] = dead ? 1u : 0u;
        }
        asm volatile("s_waitcnt vmcnt(0) lgkmcnt(0)" ::: "memory"); __builtin_amdgcn_s_barrier(); asm volatile("" ::: "memory");
        const bool bad = flag[0] != 0u;
        if (lane < 32) {
            const unsigned long long* slot = (const unsigned long long*)xbuf + (size_t)(u.pm * BM + row) * 4; float mt[4], m2[4]; float ms = 0.f;
#pragma unroll
            for (int t = 0; t < 4; ++t) { if (t < ntn) { const unsigned long long w = __hip_atomic_load(slot + t, __ATOMIC_RELAXED, __HIP_MEMORY_SCOPE_AGENT); mt[t] = __uint_as_float((unsigned)w); m2[t] = __uint_as_float((unsigned)(w >> 32)); } else { mt[t] = 0.f; m2[t] = 0.f; } ms += mt[t]; }
            const float mean = ms / (float)ntn; float q = 0.f;
#pragma unroll
            for (int t = 0; t < 4; ++t) if (t < ntn) { const float dm = mt[t] - mean; q += m2[t] + 256.0f * dm * dm; }
            S[row] = (f32x2v){mean, 1.0f / sqrtf(q / (256.0f * (float)ntn) + eps)};
        }
        asm volatile("s_waitcnt lgkmcnt(0)" ::: "memory"); __builtin_amdgcn_s_barrier(); asm volatile("" ::: "memory");
        return bad;
    }
};
struct EpiLnRes {
    static constexpr bool PERM = false, AFTER_DRAIN = true;
    const float* base; float* out; int ldc; const float* bias; PanelStats st; unsigned poison;
    __device__ __forceinline__ void fused(f32x4 (&acc)[2][2][4][2], const Unit& u, int wr, int wc, int fr, int fq, PG8_LAS unsigned char* lds, int wid, int lane) const {
        typedef float f32x2v __attribute__((ext_vector_type(2)));
        const PG8_LAS f32x2v* S = (const PG8_LAS f32x2v*)(lds + 8192);
        const int col0 = u.pn * BM + wc * 32 + 4 * fq;
#pragma unroll
        for (int bj = 0; bj < 2; ++bj)
#pragma unroll
            for (int n = 0; n < 2; ++n) { const f32x4 bv = bias ? *(const f32x4*)(bias + col0 + bj * HALF + n * 16) : (f32x4){0.f, 0.f, 0.f, 0.f};
#pragma unroll
                for (int ai = 0; ai < 2; ++ai)
#pragma unroll
                    for (int m = 0; m < 4; ++m) acc[ai][bj][m][n] += bv; }
        f32x4 pre[4][2][2];
#pragma unroll
        for (int m = 0; m < 4; ++m) { const size_t off = (size_t)(u.pm * BM + wr * 64 + m * 16 + fr) * ldc + col0;
#pragma unroll
            for (int bj = 0; bj < 2; ++bj)
#pragma unroll
                for (int n = 0; n < 2; ++n) pre[m][bj][n] = *(const f32x4*)(base + off + bj * HALF + n * 16); }
        const bool bad = st.run(acc, u, wr, wc, fr, fq, lds, wid, lane) || poison != 0u;
        const float qnan = __builtin_nanf("");
#pragma unroll
        for (int ai = 0; ai < 2; ++ai)
#pragma unroll
            for (int m = 0; m < 4; ++m) { const int r = ai * HALF + wr * 64 + m * 16 + fr; const f32x2v sr = S[r]; const size_t off = (size_t)(u.pm * BM + r) * ldc + col0;
#pragma unroll
                for (int bj = 0; bj < 2; ++bj)
#pragma unroll
                    for (int n = 0; n < 2; ++n) { const f32x4 bs = ai == 0 ? pre[m][bj][n] : *(const f32x4*)(base + off + bj * HALF + n * 16); f32x4 o = bs + (acc[ai][bj][m][n] - sr.x) * sr.y;
                        if (bad) o = (f32x4){qnan, qnan, qnan, qnan}; *(f32x4*)(out + off + bj * HALF + n * 16) = o; }
                if (m & 1) asm volatile("" ::: "memory"); }
    }
};
struct EpiLnResLn {
    static constexpr bool PERM = false, AFTER_DRAIN = true;
    const float* base; float* out; bf16_t* xn; int ldc; const float* bias; PanelStats st1, st2; unsigned poison;
    __device__ __forceinline__ void fused(f32x4 (&acc)[2][2][4][2], const Unit& u, int wr, int wc, int fr, int fq, PG8_LAS unsigned char* lds, int wid, int lane) const {
        typedef float f32x2v __attribute__((ext_vector_type(2))); typedef unsigned u32x2v __attribute__((ext_vector_type(2)));
        const PG8_LAS f32x2v* S = (const PG8_LAS f32x2v*)(lds + 8192);
        const int col0 = u.pn * BM + wc * 32 + 4 * fq;
#pragma unroll
        for (int bj = 0; bj < 2; ++bj)
#pragma unroll
            for (int n = 0; n < 2; ++n) { const f32x4 bv = bias ? *(const f32x4*)(bias + col0 + bj * HALF + n * 16) : (f32x4){0.f, 0.f, 0.f, 0.f};
#pragma unroll
                for (int ai = 0; ai < 2; ++ai)
#pragma unroll
                    for (int m = 0; m < 4; ++m) acc[ai][bj][m][n] += bv; }
        bool bad = st1.run(acc, u, wr, wc, fr, fq, lds, wid, lane) || poison != 0u;
        const float qnan = __builtin_nanf("");
#pragma unroll
        for (int ai = 0; ai < 2; ++ai)
#pragma unroll
            for (int m = 0; m < 4; ++m) { const int r = ai * HALF + wr * 64 + m * 16 + fr; const f32x2v sr = S[r]; const size_t off = (size_t)(u.pm * BM + r) * ldc + col0;
#pragma unroll
                for (int bj = 0; bj < 2; ++bj)
#pragma unroll
                    for (int n = 0; n < 2; ++n) { const f32x4 bs = *(const f32x4*)(base + off + bj * HALF + n * 16); acc[ai][bj][m][n] = bs + (acc[ai][bj][m][n] - sr.x) * sr.y; }
                asm volatile("" : "+v"(acc[ai][0][m][0]), "+v"(acc[ai][0][m][1]), "+v"(acc[ai][1][m][0]), "+v"(acc[ai][1][m][1]));
                if (m & 1) asm volatile("" ::: "memory"); }
        const bool bad1 = bad;
        bad = st2.run(acc, u, wr, wc, fr, fq, lds, wid, lane) || bad;
#pragma unroll
        for (int ai = 0; ai < 2; ++ai)
#pragma unroll
            for (int m = 0; m < 4; ++m) { const int r = ai * HALF + wr * 64 + m * 16 + fr; const f32x2v sr = S[r]; const size_t off = (size_t)(u.pm * BM + r) * ldc + col0;
#pragma unroll
                for (int bj = 0; bj < 2; ++bj)
#pragma unroll
                    for (int n = 0; n < 2; ++n) { const f32x4 x1 = acc[ai][bj][m][n]; *(f32x4*)(out + off + bj * HALF + n * 16) = bad1 ? (f32x4){qnan, qnan, qnan, qnan} : x1;
                        const f32x4 o = (x1 - sr.x) * sr.y; u32x2v w; w.x = cvt_pk_bf16(o[0], o[1]); w.y = cvt_pk_bf16(o[2], o[3]);
                        if (bad) { w.x = 0x7fc07fc0u; w.y = 0x7fc07fc0u; } *(u32x2v*)(xn + off + bj * HALF + n * 16) = w; }
                asm volatile("" ::: "memory"); }
    }
};

template <class Epi, class Sched, bool ALIGN_EPI = false, bool SP2 = false>
__device__ __forceinline__ void gemm_phase(PG8_LAS unsigned char* lds, const Gemm g, const Sched& S, const Epi& E) {
    const int tid = threadIdx.x, wid = __builtin_amdgcn_readfirstlane(tid >> 6), lane = tid & 63, wr = wid >> 2, wc = wid & 3, fr = lane & 15, fq = lane >> 4;
    const int K = g.K, nt = K / BK;
    unsigned voffA[2], voffB[2];
#pragma unroll
    for (int i = 0; i < 2; ++i) { int R, C; stage_rc(tid * 16 + i * 8192, R, C); const int Rb = Epi::PERM ? ((R & ~31) + perm32(R & 31)) : R;
        voffA[i] = (unsigned)(R * K + C) * 2u; voffB[i] = (unsigned)(Rb * K + C) * 2u; }
    const size_t kstep = (size_t)(BK * 2);
    const size_t hstep = (size_t)HALF * K * 2;
    const size_t tstep = 2 * hstep;
    const unsigned ldsw = (unsigned)wid * 1024u;
    const int aoff = lds_byte(wr * 64 + fr, fq * 8), boff = lds_byte(wc * 32 + fr, fq * 8);
#define PG8_SA(b, h) (((b) * 2 + (h)) * HTB)
#define PG8_SB(b, h) ((4 + (b) * 2 + (h)) * HTB)
#define PG8_STAGE(bufoff, gbase, voff) do { _Pragma("unroll") for (int _i = 0; _i < 2; ++_i) \
        __builtin_amdgcn_global_load_lds((const unsigned*)((const char*)(gbase) + (voff)[_i]), (PG8_LAS unsigned*)(lds + (bufoff) + ldsw + _i * 8192), 16, 0, 0); } while (0)
#define PG8_LDA(dst, b, h) do { _Pragma("unroll") for (int m = 0; m < 4; ++m) _Pragma("unroll") for (int k = 0; k < 2; ++k) dst[m][k] = *(const PG8_LAS bf16x8*)(lds + PG8_SA(b, h) + aoff + m * 2048 + k * 1024); } while (0)
#define PG8_LDB(dst, b, h) do { _Pragma("unroll") for (int n = 0; n < 2; ++n) _Pragma("unroll") for (int k = 0; k < 2; ++k) dst[n][k] = *(const PG8_LAS bf16x8*)(lds + PG8_SB(b, h) + boff + n * 2048 + k * 1024); } while (0)
#define PG8_MMA(ai, bj, At, Bt) do { __builtin_amdgcn_s_setprio(1); _Pragma("unroll") for (int m = 0; m < 4; ++m) _Pragma("unroll") for (int n = 0; n < 2; ++n) _Pragma("unroll") for (int k = 0; k < 2; ++k) \
        acc[ai][bj][m][n] = __builtin_amdgcn_mfma_f32_16x16x32_bf16(Bt[n][k], At[m][k], acc[ai][bj][m][n], 0, 0, 0); __builtin_amdgcn_s_setprio(0); } while (0)
#define PG8_WAIT_V(n) asm volatile("s_waitcnt vmcnt(" #n ")" ::: "memory")
#define PG8_WAIT_L(n) asm volatile("s_waitcnt lgkmcnt(" #n ")" ::: "memory")
#define PG8_BAR __builtin_amdgcn_s_barrier()
#define PG8_SCHED __builtin_amdgcn_sched_barrier(0)
    Unit cur, nxt; int ui = 0;
    if (!S.next(0, cur)) return;
    f32x4 acc[2][2][4][2];
#pragma unroll
    for (int a = 0; a < 2; ++a)
#pragma unroll
        for (int b = 0; b < 2; ++b)
#pragma unroll
            for (int m = 0; m < 4; ++m)
#pragma unroll
                for (int n = 0; n < 2; ++n) acc[a][b][m][n] = (f32x4){0.f, 0.f, 0.f, 0.f};
    bf16x8 At[4][2], B0[2][2], B1[2][2];
    const char* cA = (const char*)g.A + (size_t)cur.pm * tstep; const char* cB = (const char*)g.Bt + (size_t)cur.pn * tstep;
    S.a_ready(cur);
    if constexpr (SP2) {
        PG8_STAGE(PG8_SB(0, 0), cB, voffB); PG8_STAGE(PG8_SB(0, 1), cB + hstep, voffB); PG8_STAGE(PG8_SA(0, 0), cA, voffA); PG8_STAGE(PG8_SA(0, 1), cA + hstep, voffA);
        if (wr == 1) PG8_BAR;
        PG8_WAIT_V(2); PG8_BAR;
        PG8_STAGE(PG8_SB(1, 0), cB + kstep, voffB); PG8_STAGE(PG8_SA(1, 0), cA + kstep, voffA); PG8_STAGE(PG8_SB(1, 1), cB + hstep + kstep, voffB);
        PG8_WAIT_V(6); PG8_BAR;
    } else {
        PG8_STAGE(PG8_SB(0, 0), cB, voffB); PG8_STAGE(PG8_SA(0, 0), cA, voffA); PG8_STAGE(PG8_SB(0, 1), cB + hstep, voffB); PG8_STAGE(PG8_SA(0, 1), cA + hstep, voffA);
        if (wr == 1) PG8_BAR;
        PG8_WAIT_V(4); PG8_BAR;
        PG8_STAGE(PG8_SB(1, 0), cB + kstep, voffB); PG8_STAGE(PG8_SA(1, 0), cA + kstep, voffA); PG8_STAGE(PG8_SB(1, 1), cB + hstep + kstep, voffB);
        PG8_WAIT_V(6); PG8_BAR;
    }
    for (;;) {
        const bool has_next = S.next(ui + 1, nxt);
        const char* nA = has_next ? (const char*)g.A + (size_t)nxt.pm * tstep : cA; const char* nB = has_next ? (const char*)g.Bt + (size_t)nxt.pn * tstep : cB;
        for (int t = 0; t < nt; t += 2) {
            const bool last = (t == nt - 2);
            const char* a1 = cA + (size_t)(t + 1) * kstep;
            const char* a2 = last ? nA : cA + (size_t)(t + 2) * kstep; const char* b2 = last ? nB : cB + (size_t)(t + 2) * kstep;
            const char* a3 = a2 + kstep; const char* b3 = b2 + kstep;
            if (last && has_next) S.a_ready(nxt);
            if constexpr (SP2) {
            PG8_LDB(B0, 0, 0); PG8_LDB(B1, 0, 1); PG8_SCHED; PG8_LDA(At, 0, 0); PG8_STAGE(PG8_SA(1, 1), a1 + hstep, voffA);
            PG8_WAIT_V(8); PG8_WAIT_L(0); PG8_BAR; PG8_MMA(0, 0, At, B0); PG8_MMA(0, 1, At, B1); PG8_BAR; PG8_SCHED;
            PG8_LDA(At, 0, 1); PG8_STAGE(PG8_SB(0, 0), b2, voffB); PG8_STAGE(PG8_SB(0, 1), b2 + hstep, voffB); PG8_STAGE(PG8_SA(0, 0), a2, voffA);
            PG8_WAIT_V(8); PG8_WAIT_L(0); PG8_BAR; PG8_MMA(1, 0, At, B0); PG8_MMA(1, 1, At, B1); PG8_BAR; PG8_SCHED;
            PG8_LDB(B0, 1, 0); PG8_LDB(B1, 1, 1); PG8_SCHED; PG8_LDA(At, 1, 0); PG8_STAGE(PG8_SA(0, 1), a2 + hstep, voffA);
            PG8_WAIT_V(8); PG8_WAIT_L(0); PG8_BAR; PG8_MMA(0, 0, At, B0); PG8_MMA(0, 1, At, B1); PG8_BAR; PG8_SCHED;
            PG8_LDA(At, 1, 1); PG8_STAGE(PG8_SB(1, 0), b3, voffB); PG8_STAGE(PG8_SB(1, 1), b3 + hstep, voffB); PG8_STAGE(PG8_SA(1, 0), a3, voffA);
            PG8_WAIT_V(8); PG8_WAIT_L(0); PG8_BAR; PG8_MMA(1, 0, At, B0); PG8_MMA(1, 1, At, B1); PG8_BAR; PG8_SCHED;
            } else {
            PG8_LDB(B0, 0, 0); PG8_SCHED; PG8_LDA(At, 0, 0); PG8_STAGE(PG8_SA(1, 1), a1 + hstep, voffA);
            PG8_WAIT_L(8); PG8_BAR; PG8_WAIT_L(0); PG8_MMA(0, 0, At, B0); PG8_BAR; PG8_SCHED;
            PG8_LDB(B1, 0, 1); PG8_STAGE(PG8_SB(0, 0), b2, voffB);
            PG8_BAR; PG8_WAIT_L(0); PG8_MMA(0, 1, At, B1); PG8_BAR;
            PG8_LDA(At, 0, 1); PG8_STAGE(PG8_SA(0, 0), a2, voffA);
            PG8_BAR; PG8_WAIT_L(0); PG8_MMA(1, 0, At, B0); PG8_BAR; PG8_SCHED;
            PG8_STAGE(PG8_SB(0, 1), b2 + hstep, voffB);
            PG8_WAIT_V(6); PG8_BAR; PG8_MMA(1, 1, At, B1); PG8_BAR;
            PG8_LDB(B0, 1, 0); PG8_SCHED; PG8_LDA(At, 1, 0); PG8_STAGE(PG8_SA(0, 1), a2 + hstep, voffA);
            PG8_WAIT_L(8); PG8_BAR; PG8_WAIT_L(0); PG8_MMA(0, 0, At, B0); PG8_BAR; PG8_SCHED;
            PG8_LDB(B1, 1, 1); PG8_STAGE(PG8_SB(1, 0), b3, voffB);
            PG8_BAR; PG8_WAIT_L(0); PG8_MMA(0, 1, At, B1); PG8_BAR;
            PG8_LDA(At, 1, 1); PG8_STAGE(PG8_SA(1, 0), a3, voffA);
            PG8_BAR; PG8_WAIT_L(0); PG8_MMA(1, 0, At, B0); PG8_BAR; PG8_SCHED;
            PG8_STAGE(PG8_SB(1, 1), b3 + hstep, voffB);
            PG8_WAIT_V(6); PG8_BAR; PG8_MMA(1, 1, At, B1); PG8_BAR;
            }
        }
        if constexpr (ALIGN_EPI) { if (wr == 0) PG8_BAR; }
        if constexpr (!Epi::AFTER_DRAIN) { E(acc, cur, wr, wc, fr, fq); S.done(cur); }
        if (!has_next) break;
#pragma unroll
        for (int a = 0; a < 2; ++a)
#pragma unroll
            for (int b = 0; b < 2; ++b)
#pragma unroll
                for (int m = 0; m < 4; ++m)
#pragma unroll
                    for (int n = 0; n < 2; ++n) acc[a][b][m][n] = (f32x4){0.f, 0.f, 0.f, 0.f};
        cur = nxt; cA = nA; cB = nB; ++ui;
        if constexpr (ALIGN_EPI) { if (wr == 1) PG8_BAR; }
    }
    PG8_WAIT_V(0);
    if constexpr (!ALIGN_EPI) { if (wr == 0) PG8_BAR; }
    PG8_BAR;
    if constexpr (Epi::AFTER_DRAIN) { E.fused(acc, cur, wr, wc, fr, fq, lds, wid, lane); S.done(cur); }
#undef PG8_SA
#undef PG8_SB
#undef PG8_STAGE
#undef PG8_LDA
#undef PG8_LDB
#undef PG8_MMA
#undef PG8_WAIT_V
#undef PG8_WAIT_L
#undef PG8_BAR
#undef PG8_SCHED
}
}


constexpr int BATCH = 8, SEQ = 4096, DM = 1024, MTOK = BATCH * SEQ;
constexpr int NH = 8, HD = 64;
constexpr int NPROJ = 4224, NPROJ_PAD = 4352;
constexpr int C_R = 0, C_K = 512, C_V = 1024, C_Q = 1536, C_KA = 2048, C_VA = 2560, C_G = 3072, C_WD = 4096, C_AD = 4160;
__host__ __device__ __forceinline__ int oldcol(int n) { return n < 1536 ? n : (n < 4096 ? n + 128 : n - 2560); }
constexpr float RMS_EPS = 1e-6f, GN_EPS = 64e-5f;

#define GAS __attribute__((address_space(1)))
#define LAS __attribute__((address_space(3)))
typedef unsigned short bf16;
typedef unsigned v4u __attribute__((ext_vector_type(4)));
typedef float f32x4 __attribute__((ext_vector_type(4)));
__device__ __forceinline__ unsigned f2bf(float f) { unsigned u = __builtin_bit_cast(unsigned, f); return (u + 0x7fffu + ((u >> 16) & 1u)) >> 16; }
__device__ __forceinline__ unsigned pk2(float lo, float hi) { return f2bf(lo) | (f2bf(hi) << 16); }
__device__ __forceinline__ float bf2f(bf16 v) { return __builtin_bit_cast(float, (unsigned)v << 16); }
__device__ __forceinline__ float wave_sum(float v) {
#pragma unroll
    for (int o = 1; o < 64; o <<= 1) v += __shfl_xor(v, o);
    return v;
}
__device__ __forceinline__ float wave_max(float v) {
#pragma unroll
    for (int o = 1; o < 64; o <<= 1) v = fmaxf(v, __shfl_xor(v, o));
    return v;
}
#define LDS_WAIT() asm volatile("s_waitcnt lgkmcnt(0)" ::: "memory")

constexpr size_t MiB = 1u << 20;
constexpr size_t WS_CTL = 0;
constexpr size_t WS_WIN = 2 * MiB;
constexpr size_t WS_WOUT = 11 * MiB;
constexpr size_t WS_KMEAN = 13 * MiB;
constexpr size_t WS_W2T = 13 * MiB + 512 * 1024, WS_A2T = WS_W2T + 65536;
constexpr size_t WS_XN = 16 * MiB;
constexpr size_t WS_MF = 16 * MiB;
constexpr size_t WS_RKV = 80 * MiB;
constexpr size_t WS_YBUF = 344 * MiB;
constexpr size_t WS_SEL = 14 * MiB;
constexpr size_t WS_PART = 80 * MiB;
constexpr size_t WS_ML = 176 * MiB;
constexpr size_t WS_WDAD = 176 * MiB;
constexpr size_t WS_QKVA = 184 * MiB;
constexpr size_t WS_GATES = 280 * MiB;
constexpr size_t WS_NA = 344 * MiB, WS_PF = 408 * MiB, WS_QA = 440 * MiB, WS_BV = 472 * MiB;
constexpr size_t WS_WDAD2 = 504 * MiB;
constexpr size_t WS_OBUF = 208 * MiB;
constexpr size_t WS_END = 512 * MiB;

__device__ __forceinline__ void p0_transpose_item(const float* W, int K, int N, bf16* WT, bool perm, LAS float* scr, int item, int lane) {
    const int nblk_new = perm ? (NPROJ / 32) : (N / 32);
    const int kb = item / nblk_new, nb = item % nblk_new, k0 = 64 * kb, n0new = 32 * nb, n0 = perm ? oldcol(n0new) : n0new;
#pragma unroll 8
    for (int i = 0; i < 32; ++i) { const int kk = 2 * i + (lane >> 5); scr[kk * 33 + (lane & 31)] = W[(size_t)(k0 + kk) * N + n0 + (lane & 31)]; }
    LDS_WAIT(); asm volatile("" ::: "memory");
    const int c = lane & 7;
#pragma unroll
    for (int j = 0; j < 4; ++j) { const int n = (lane >> 3) + 8 * j; const LAS float* s = scr + (8 * c) * 33 + n;
        v4u o; o.x = pk2(s[0 * 33], s[1 * 33]); o.y = pk2(s[2 * 33], s[3 * 33]); o.z = pk2(s[4 * 33], s[5 * 33]); o.w = pk2(s[6 * 33], s[7 * 33]);
        *(GAS v4u*)(WT + (size_t)(n0new + n) * K + k0 + 8 * c) = o; }
    LDS_WAIT(); asm volatile("" ::: "memory");
}
__device__ __forceinline__ void rms_row_to_bf16(const float* xrow, const float* g, bf16* orow, int lane) {
    const GAS f32x4* xr = (const GAS f32x4*)xrow + lane;
    const GAS f32x4* gr = (const GAS f32x4*)g + lane;
    f32x4 v[4]; float s = 0.f;
#pragma unroll
    for (int j = 0; j < 4; ++j) { v[j] = xr[64 * j]; s += (v[j].x * v[j].x + v[j].y * v[j].y) + (v[j].z * v[j].z + v[j].w * v[j].w); }
    const float rs = 1.f / sqrtf(wave_sum(s) * (1.f / DM) + RMS_EPS);
    GAS unsigned long long* o8 = (GAS unsigned long long*)orow + lane;
#pragma unroll
    for (int j = 0; j < 4; ++j) { const f32x4 gg = gr[64 * j];
        o8[64 * j] = (unsigned long long)pk2(v[j].x * rs * gg.x, v[j].y * rs * gg.y) | ((unsigned long long)pk2(v[j].z * rs * gg.z, v[j].w * rs * gg.w) << 32); }
}

#define XB_TMO      128
#define XB_XCNT(j)  (256  + 64 * (j))
#define XB_XSUB(j)  (1280 + 64 * (j))
#define XB_XGEN(j)  (2304 + 64 * (j))
#define XB_TOP      3328
#define XB_TOPGEN   3392
#define XCD_BAR_WORDS 3456
#define XB_SPIN_CAP (1u << 18)

__device__ __forceinline__ unsigned xb_ld(unsigned* p)              { return __hip_atomic_load(p, __ATOMIC_RELAXED, __HIP_MEMORY_SCOPE_AGENT); }
__device__ __forceinline__ unsigned xb_add(unsigned* p, unsigned v) { return __hip_atomic_fetch_add(p, v, __ATOMIC_RELAXED, __HIP_MEMORY_SCOPE_AGENT); }
__device__ __forceinline__ unsigned xb_xcc_id() { return (unsigned)__builtin_amdgcn_s_getreg((3 << 11) | 20) & 0xFu; }
#define XB_SPIN(cond, bar) do { unsigned _sp = 0; while (cond) { __builtin_amdgcn_s_sleep(1); \
    if ((++_sp & 255u) == 0u) { if (xb_ld(&(bar)[XB_TMO])) break; if (_sp > XB_SPIN_CAP) { atomicAdd(&(bar)[XB_TMO], 1u); break; } } } } while (0)

struct XcdBarrier {
    unsigned* bar; unsigned x;
    volatile LAS unsigned* st;
};

__device__ __forceinline__ XcdBarrier xcd_barrier_post(unsigned* bar, volatile LAS unsigned* st) {
    XcdBarrier b; b.bar = bar; b.x = xb_xcc_id(); b.st = st;
    if (threadIdx.x == 0) (void)xb_add(&bar[XB_XCNT(b.x)], 1u);
    return b;
}
__device__ __forceinline__ void xcd_barrier_complete(unsigned* bar, unsigned x, unsigned& nloc, unsigned& nx) {
    const unsigned G = gridDim.x * gridDim.y * gridDim.z;
    unsigned sum, cnt, mine, sp = 0u;
    for (;;) {
        sum = 0u; cnt = 0u; mine = 0u;
#pragma unroll
        for (unsigned j = 0; j < 16; ++j) { const unsigned c = xb_ld(&bar[XB_XCNT(j)]); sum += c; cnt += (c > 0u) ? 1u : 0u; mine = (j == x) ? c : mine; }
        if (sum == G) break;
        __builtin_amdgcn_s_sleep(1);
        if ((++sp & 255u) == 0u) { if (xb_ld(&bar[XB_TMO])) break; if (sp > XB_SPIN_CAP) { atomicAdd(&bar[XB_TMO], 1u); break; } }
    }
    nloc = mine > 0u ? mine : 1u; nx = cnt > 0u ? cnt : 1u;
}

__device__ __forceinline__ void xcd_barrier(const XcdBarrier& b) {
    asm volatile("s_waitcnt vmcnt(0)" ::: "memory");
    __syncthreads();
    if (threadIdx.x == 0) {
        unsigned* bar = b.bar;
        __builtin_amdgcn_s_waitcnt(0);
        unsigned nloc = b.st[0], nx = b.st[1];
        if (nloc == 0u) { xcd_barrier_complete(bar, b.x, nloc, nx); b.st[0] = nloc; b.st[1] = nx; }
        const unsigned old = xb_add(&bar[XB_XSUB(b.x)], 1u);
        const unsigned gen = old / nloc;
        if (old + 1u == (gen + 1u) * nloc) {
            __builtin_amdgcn_fence(__ATOMIC_RELEASE, "agent");
            asm volatile("s_waitcnt vmcnt(0)" ::: "memory");
            const unsigned og = xb_add(&bar[XB_TOP], 1u);
            const unsigned tg = og / nx;
            if (og + 1u == (tg + 1u) * nx) xb_add(&bar[XB_TOPGEN], 1u);
            else XB_SPIN(xb_ld(&bar[XB_TOPGEN]) == tg, bar);
            __builtin_amdgcn_fence(__ATOMIC_ACQUIRE, "agent");
            xb_add(&bar[XB_XGEN(b.x)], 1u);
            asm volatile("s_waitcnt vmcnt(0)" ::: "memory");
        } else {
            XB_SPIN(xb_ld(&bar[XB_XGEN(b.x)]) == gen, bar);
            __builtin_amdgcn_fence(__ATOMIC_ACQUIRE, "agent");
            asm volatile("s_waitcnt vmcnt(0)" ::: "memory");
        }
    }
    __syncthreads();
}


constexpr int NWAVES = 8;
constexpr int RING_OFF = 0, RING_BYTES = 131072;
constexpr int LDSCTL_OFF = 147456 - 512, MISC_OFF = LDSCTL_OFF + 320;
constexpr int LDS_BYTES = 147456;
constexpr size_t CTL_ZERO_BYTES = 1 * MiB;
constexpr int CW_BAR = 4096;
constexpr int CW_QUEUE = 64;
typedef GAS unsigned gu32;
#define RLX_AGENT __ATOMIC_RELAXED, __HIP_MEMORY_SCOPE_AGENT

struct Args { const float* in[15]; float* out; unsigned char* ws; };

__device__ __forceinline__ void phase_prologue(const Args& a, LAS unsigned char* lds, int tid, int lane, int wave) {
    LAS float* scr = (LAS float*)(lds + wave * 16384);
    const int gw = blockIdx.x * 8 + wave, NGW = gridDim.x * 8;
    bf16* WinT = (bf16*)(a.ws + WS_WIN); bf16* WoutT = (bf16*)(a.ws + WS_WOUT); bf16* XN = (bf16*)(a.ws + WS_XN);
    constexpr int I_IN = (DM / 64) * (NPROJ / 32), I_OUT = (DM / 64) * (DM / 32);
    for (int it = gw; it < I_IN + I_OUT; it += NGW) {
        if (it < I_IN) p0_transpose_item(a.in[2], DM, NPROJ, WinT, true, scr, it, lane);
        else p0_transpose_item(a.in[13], DM, DM, WoutT, false, scr, it - I_IN, lane);
    }
    { v4u z = {0u, 0u, 0u, 0u}; GAS v4u* p = (GAS v4u*)(WinT + (size_t)NPROJ * DM);
      for (int i = blockIdx.x * 512 + tid; i < 128 * 1024 * 2 / 16; i += gridDim.x * 512) p[i] = z; }
    { bf16* W2T = (bf16*)(a.ws + WS_W2T); bf16* A2T = (bf16*)(a.ws + WS_A2T);
      for (int i = blockIdx.x * 512 + tid; i < 512 * 64; i += gridDim.x * 512) { const int ch = i >> 6, j = i & 63; W2T[i] = (bf16)f2bf(a.in[5][j * 512 + ch]); A2T[i] = (bf16)f2bf(a.in[7][j * 512 + ch]); } }
    for (int m = gw; m < MTOK; m += NGW) rms_row_to_bf16(a.in[0] + (size_t)m * DM, a.in[1], XN + (size_t)m * DM, lane);
}

__device__ __forceinline__ void phase_final(const Args& a, int lane, int wave) {
    const int gw = blockIdx.x * 8 + wave, NGW = gridDim.x * 8;
    const float* O = (const float*)(a.ws + WS_OBUF);
    for (int m = gw; m < MTOK; m += NGW) {
        const f32x4* orow = (const f32x4*)(O + (size_t)m * DM) + lane; const f32x4* xr = (const f32x4*)(a.in[0] + (size_t)m * DM) + lane; const f32x4* gr = (const f32x4*)a.in[14] + lane;
        f32x4 v[4]; float s = 0.f;
#pragma unroll
        for (int j = 0; j < 4; ++j) { v[j] = orow[64 * j]; s += (v[j].x * v[j].x + v[j].y * v[j].y) + (v[j].z * v[j].z + v[j].w * v[j].w); }
        const float rs = 1.f / sqrtf(wave_sum(s) * (1.f / DM) + RMS_EPS);
        f32x4* outr = (f32x4*)(a.out + (size_t)m * DM) + lane;
#pragma unroll
        for (int j = 0; j < 4; ++j) outr[64 * j] = xr[64 * j] + v[j] * rs * gr[64 * j];
    }
}

__device__ __forceinline__ void phase_kmean(const Args& a, int tid) {
    const bf16* qkva = (const bf16*)(a.ws + WS_QKVA); float* km = (float*)(a.ws + WS_KMEAN);
    for (int u = blockIdx.x; u < BATCH * 16; u += gridDim.x) {
        const int b = u / 16, n = u % 16, c = tid;
        const bf16* p = qkva + ((size_t)b * SEQ + n * 256) * 1536 + 512 + c;
        float s = 0.f;
        for (int t = 0; t < 256; ++t) s += bf2f(p[(size_t)t * 1536]);
        km[(((size_t)b * NH + (c >> 6)) * 16 + n) * 64 + (c & 63)] = s * (1.f / 256.f);
    }
}

#define WAVE_LDS_SYNC() do { asm volatile("s_waitcnt lgkmcnt(0)" ::: "memory"); } while (0)

typedef float f32x16 __attribute__((ext_vector_type(16)));
typedef short bf16x8_t __attribute__((ext_vector_type(8)));
typedef unsigned u32x4_t __attribute__((ext_vector_type(4)));
typedef unsigned u32x2_t __attribute__((ext_vector_type(2)));
struct P8 { unsigned w[8]; };
#define MFMA32(a, b, c) __builtin_amdgcn_mfma_f32_32x32x16_bf16((a), (b), (c), 0, 0, 0)
__device__ __forceinline__ unsigned cvtpk(float lo, float hi) { typedef float f2 __attribute__((ext_vector_type(2))); typedef __bf16 b2 __attribute__((ext_vector_type(2))); f2 v = {lo, hi}; b2 b = __builtin_convertvector(v, b2); return __builtin_bit_cast(unsigned, b); }
__device__ __forceinline__ float bflo(unsigned u) { return __builtin_bit_cast(float, u << 16); }
__device__ __forceinline__ float bfhi(unsigned u) { return __builtin_bit_cast(float, u & 0xffff0000u); }
__device__ __forceinline__ P8 pack_tile(const f32x16& x) { P8 p;
#pragma unroll
    for (int q = 0; q < 8; ++q) p.w[q] = cvtpk(x[2 * q], x[2 * q + 1]);
    return p; }
__device__ __forceinline__ f32x16 unpack_tile(const P8& p) { f32x16 x;
#pragma unroll
    for (int q = 0; q < 8; ++q) { x[2 * q] = bflo(p.w[q]); x[2 * q + 1] = bfhi(p.w[q]); }
    return x; }
template <int S> __device__ __forceinline__ bf16x8_t frag(const P8& p) { u32x4_t v = {p.w[4 * S], p.w[4 * S + 1], p.w[4 * S + 2], p.w[4 * S + 3]}; return __builtin_bit_cast(bf16x8_t, v); }
__device__ __forceinline__ f32x16 zero16() { f32x16 z;
#pragma unroll
    for (int i = 0; i < 16; ++i) z[i] = 0.f;
    return z; }
__device__ __forceinline__ f32x16 mm1(const P8& a, const P8& b, f32x16 acc) { acc = MFMA32(frag<0>(a), frag<0>(b), acc); acc = MFMA32(frag<1>(a), frag<1>(b), acc); return acc; }

constexpr int RW_NUNITS = BATCH * NH * (SEQ / 32);
constexpr size_t RW_MF_BYTES = 8192, RW_NA_BYTES = 8192, RW_PF_BYTES = 4096, RW_QA_BYTES = 4096, RW_BV_BYTES = 4096;
constexpr int PT_MU = 0, PT_W0 = 1664, PT_A0 = 2176, PT_KK = 2688, PT_KA = 3200, PT_RK = 3712, PT_FLOATS = 4224;
constexpr int PREP_PT_BYTES = 17408, PREP_WAVE_BYTES = 16128;
constexpr int STG_PITCH = 144;
constexpr int STG_BYTES = 33 * STG_PITCH;
constexpr int AIMG_PITCH = 36;

struct RwkvBufs { const bf16* rkv; const bf16* wdad2; bf16* mf; bf16* na; bf16* pf; bf16* qa; bf16* bv; const bf16* w2t; const bf16* a2t; };

__device__ __forceinline__ void stage_tile(LAS unsigned char* img, const bf16* src_row0  , int ldsrc, bool first, int lane) {
#pragma unroll
    for (int it = 0; it < 5; ++it) {
        const int q = lane + 64 * it;
        if (q < 264) { const int row = q >> 3, ch = q & 7;
            v4u v = {0u, 0u, 0u, 0u};
            if (!(first && row == 0)) v = *(const GAS v4u*)(src_row0 + (ptrdiff_t)(row - 1) * ldsrc + ch * 8);
            *(LAS v4u*)(img + row * STG_PITCH + ch * 16) = v; }
    }
}

__device__ __forceinline__ void rwkv_prep_unit(const RwkvBufs& B, int unit, LAS unsigned char* wl, const LAS float* pt, int lane_in) {
    int lane = lane_in; asm volatile("" : "+v"(lane));
    const int r = lane & 31, lh = lane >> 5;
    const int c = unit & 127, hd = (unit >> 7) & 7, b = unit >> 10;
    const size_t m0 = (size_t)b * SEQ + c * 32;
    LAS unsigned char* S0 = wl; LAS unsigned char* S1 = wl + STG_BYTES; LAS unsigned char* S2 = wl + 2 * STG_BYTES;
    LAS float* cumc = (LAS float*)(wl + 3 * STG_BYTES);
    LAS float* aimg = (LAS float*)wl;
    stage_tile(S0, B.rkv + m0 * 1536 + hd * 64, 1536, c == 0, lane);
    stage_tile(S1, B.rkv + m0 * 1536 + 512 + hd * 64, 1536, c == 0, lane);
    stage_tile(S2, B.rkv + m0 * 1536 + 1024 + hd * 64, 1536, c == 0, lane);
    f32x16 lwv[2], dav[2];
    {
        bf16x8_t tw[4], ad[4];
#pragma unroll
        for (int s = 0; s < 4; ++s) { tw[s] = *(const GAS bf16x8_t*)(B.wdad2 + (m0 + r) * 128 + 16 * s + 8 * lh); ad[s] = *(const GAS bf16x8_t*)(B.wdad2 + (m0 + r) * 128 + 64 + 16 * s + 8 * lh); }
#pragma unroll
        for (int mt = 0; mt < 2; ++mt) { f32x16 a1 = zero16(), a2 = zero16();
#pragma unroll
            for (int s = 0; s < 4; ++s) { const bf16x8_t wa = *(const GAS bf16x8_t*)(B.w2t + (size_t)(hd * 64 + 32 * mt + r) * 64 + 16 * s + 8 * lh);
                const bf16x8_t aa = *(const GAS bf16x8_t*)(B.a2t + (size_t)(hd * 64 + 32 * mt + r) * 64 + 16 * s + 8 * lh);
                a1 = MFMA32(wa, tw[s], a1); a2 = MFMA32(aa, ad[s], a2); }
            lwv[mt] = a1; dav[mt] = a2; }
    }
#pragma unroll
    for (int it = 0; it < 2; ++it)
#pragma unroll
        for (int g = 0; g < 4; ++g) { const f32x4 w0v = *(const LAS f32x4*)(pt + PT_W0 + hd * 64 + 32 * it + 8 * g + 4 * lh);
#pragma unroll
            for (int e = 0; e < 4; ++e) { const int i = 4 * g + e; const float x = -(w0v[e] + lwv[it][i]);
                const float sp = fmaxf(x, 0.f) + __logf(1.f + __expf(-fabsf(x)));
                lwv[it][i] = -__expf(-sp - 0.5f); } }
#pragma unroll
    for (int d = 1; d < 32; d <<= 1)
#pragma unroll
        for (int it = 0; it < 2; ++it)
#pragma unroll
            for (int i = 0; i < 16; ++i) { const float y = __shfl_up(lwv[it][i], d, 32); if (r >= d) lwv[it][i] += y; }
    if (r == 31) {
#pragma unroll
        for (int it = 0; it < 2; ++it)
#pragma unroll
            for (int g = 0; g < 4; ++g) { f32x4 v = {lwv[it][4 * g], lwv[it][4 * g + 1], lwv[it][4 * g + 2], lwv[it][4 * g + 3]}; *(LAS f32x4*)(cumc + 32 * it + 8 * g + 4 * lh) = v; }
    }
#pragma unroll
    for (int it = 0; it < 2; ++it)
#pragma unroll
        for (int i = 0; i < 16; ++i) lwv[it][i] = __expf(lwv[it][i]);
    asm volatile("" ::: "memory");
    float n2 = 0.f;
#pragma unroll
    for (int it = 0; it < 2; ++it)
#pragma unroll
        for (int g = 0; g < 4; ++g) { const int cl0 = 32 * it + 8 * g + 4 * lh;
            const u32x2_t kc = *(const LAS u32x2_t*)(S1 + (r + 1) * STG_PITCH + cl0 * 2), kp = *(const LAS u32x2_t*)(S1 + r * STG_PITCH + cl0 * 2);
            const f32x4 muk = *(const LAS f32x4*)(pt + PT_MU + 512 + hd * 64 + cl0), kkv = *(const LAS f32x4*)(pt + PT_KK + hd * 64 + cl0);
            const float k0 = bflo(kc.x), k1 = bfhi(kc.x), k2 = bflo(kc.y), k3 = bfhi(kc.y), p0 = bflo(kp.x), p1 = bfhi(kp.x), p2 = bflo(kp.y), p3 = bfhi(kp.y);
            const float a0 = (k0 + (p0 - k0) * muk[0]) * kkv[0], a1 = (k1 + (p1 - k1) * muk[1]) * kkv[1], a2 = (k2 + (p2 - k2) * muk[2]) * kkv[2], a3 = (k3 + (p3 - k3) * muk[3]) * kkv[3];
            n2 += (a0 * a0 + a1 * a1) + (a2 * a2 + a3 * a3); asm volatile("" ::: "memory"); }
    n2 += __shfl_xor(n2, 32);
    const float kinv = 1.f / fmaxf(sqrtf(n2), 1e-12f);
    P8 ACT[2], RCT[2], BCT[2], KCT[2];
    float bon = 0.f;
#pragma unroll
    for (int it = 0; it < 2; ++it)
#pragma unroll
        for (int g = 0; g < 4; ++g) { const int cl0 = 32 * it + 8 * g + 4 * lh, ch0 = hd * 64 + cl0;
            const u32x2_t rc = *(const LAS u32x2_t*)(S0 + (r + 1) * STG_PITCH + cl0 * 2), rp = *(const LAS u32x2_t*)(S0 + r * STG_PITCH + cl0 * 2);
            const u32x2_t kc = *(const LAS u32x2_t*)(S1 + (r + 1) * STG_PITCH + cl0 * 2), kp = *(const LAS u32x2_t*)(S1 + r * STG_PITCH + cl0 * 2);
            const f32x4 mur = *(const LAS f32x4*)(pt + PT_MU + ch0), muk = *(const LAS f32x4*)(pt + PT_MU + 512 + ch0);
            const f32x4 a0v = *(const LAS f32x4*)(pt + PT_A0 + ch0), kkv = *(const LAS f32x4*)(pt + PT_KK + ch0), kav = *(const LAS f32x4*)(pt + PT_KA + ch0), rkv = *(const LAS f32x4*)(pt + PT_RK + ch0);
            const float rr[4] = {bflo(rc.x), bfhi(rc.x), bflo(rc.y), bfhi(rc.y)}, rq[4] = {bflo(rp.x), bfhi(rp.x), bflo(rp.y), bfhi(rp.y)};
            const float kr[4] = {bflo(kc.x), bfhi(kc.x), bflo(kc.y), bfhi(kc.y)}, kq[4] = {bflo(kp.x), bfhi(kp.x), bflo(kp.y), bfhi(kp.y)};
            float oA[4], oR[4], oB[4], oK[4];
#pragma unroll
            for (int e = 0; e < 4; ++e) { const int i = 4 * g + e;
                const float rs = rr[e] + (rq[e] - rr[e]) * mur[e], ks = kr[e] + (kq[e] - kr[e]) * muk[e];
                const float aa = __builtin_amdgcn_rcpf(1.f + __expf(-(a0v[e] + dav[it][i])));
                const float kk = ks * kkv[e] * kinv;
                const float kpr = ks * (1.f + (aa - 1.f) * kav[e]);
                bon += rs * kpr * rkv[e];
                const float e2 = lwv[it][i]; float e1 = __shfl_up(e2, 1, 32); e1 = (r == 0) ? 1.f : e1;
                const float e3 = __builtin_amdgcn_rcpf(e2);
                oA[e] = -kk * e1; oR[e] = rs * e2; oB[e] = kk * aa * e3; oK[e] = kpr * e3; }
            ACT[it].w[2 * g] = cvtpk(oA[0], oA[1]); ACT[it].w[2 * g + 1] = cvtpk(oA[2], oA[3]);
            RCT[it].w[2 * g] = cvtpk(oR[0], oR[1]); RCT[it].w[2 * g + 1] = cvtpk(oR[2], oR[3]);
            BCT[it].w[2 * g] = cvtpk(oB[0], oB[1]); BCT[it].w[2 * g + 1] = cvtpk(oB[2], oB[3]);
            KCT[it].w[2 * g] = cvtpk(oK[0], oK[1]); KCT[it].w[2 * g + 1] = cvtpk(oK[2], oK[3]);
            asm volatile("" ::: "memory"); }
    bon += __shfl_xor(bon, 32);
    const float gam0 = __expf(cumc[r]), gam1 = __expf(cumc[32 + r]);
    LDS_WAIT(); asm volatile("" ::: "memory");
    { f32x16 acc = zero16(); acc = mm1(ACT[0], BCT[0], acc); acc = mm1(ACT[1], BCT[1], acc);
#pragma unroll
      for (int g = 0; g < 4; ++g) { f32x4 v;
#pragma unroll
          for (int e = 0; e < 4; ++e) v[e] = (8 * g + 4 * lh + e > r) ? acc[4 * g + e] : 0.f;
          *(LAS f32x4*)(aimg + r * AIMG_PITCH + 8 * g + 4 * lh) = v; } }
    float Tr[32];
#pragma unroll
    for (int j = 0; j < 32; ++j) Tr[j] = (j == r) ? 1.f : 0.f;
    LDS_WAIT(); asm volatile("" ::: "memory");
#pragma unroll
    for (int j = 30; j >= 0; --j) { float acc = 0.f;
#pragma unroll
        for (int q = (j + 1) >> 2; q < 8; ++q) { const f32x4 av = *(const LAS f32x4*)(aimg + j * AIMG_PITCH + 4 * q);
            acc += Tr[4 * q] * av[0] + Tr[4 * q + 1] * av[1] + Tr[4 * q + 2] * av[2] + Tr[4 * q + 3] * av[3]; }
        Tr[j] = (r > j) ? acc : Tr[j]; }
    P8 XT;
#pragma unroll
    for (int q = 0; q < 8; ++q) { const int i0 = 2 * q, i1 = 2 * q + 1;
        const float v0 = lh ? Tr[(i0 & 3) + 8 * (i0 >> 2) + 4] : Tr[(i0 & 3) + 8 * (i0 >> 2)], v1 = lh ? Tr[(i1 & 3) + 8 * (i1 >> 2) + 4] : Tr[(i1 & 3) + 8 * (i1 >> 2)];
        XT.w[q] = cvtpk(v0, v1); }
    P8 Aak, Arb, Ark;
    { f32x16 acc = zero16(); acc = mm1(KCT[0], ACT[0], acc); acc = mm1(KCT[1], ACT[1], acc);
#pragma unroll
      for (int i = 0; i < 16; ++i) acc[i] = ((i & 3) + 8 * (i >> 2) + 4 * lh < r) ? acc[i] : 0.f;
      Aak = pack_tile(acc); }
    { f32x16 acc = zero16(); acc = mm1(BCT[0], RCT[0], acc); acc = mm1(BCT[1], RCT[1], acc);
#pragma unroll
      for (int i = 0; i < 16; ++i) acc[i] = ((i & 3) + 8 * (i >> 2) + 4 * lh <= r) ? acc[i] : 0.f;
      Arb = pack_tile(acc); }
    { f32x16 acc = zero16(); acc = mm1(KCT[0], RCT[0], acc); acc = mm1(KCT[1], RCT[1], acc);
#pragma unroll
      for (int i = 0; i < 16; ++i) acc[i] = ((i & 3) + 8 * (i >> 2) + 4 * lh <= r) ? acc[i] : 0.f;
      Ark = pack_tile(acc); }
    P8 If;
#pragma unroll
    for (int q = 0; q < 8; ++q) { const int i0 = 2 * q, i1 = 2 * q + 1;
        const unsigned lo = ((i0 & 3) + 8 * (i0 >> 2) + 4 * lh == r) ? 0x3f80u : 0u, hi = ((i1 & 3) + 8 * (i1 >> 2) + 4 * lh == r) ? 0x3f800000u : 0u; If.w[q] = lo | hi; }
    P8 VC[2], AC[2], BhC[2], KhC[2];
#pragma unroll
    for (int ct = 0; ct < 2; ++ct) {
        AC[ct] = pack_tile(mm1(ACT[ct], If, zero16()));
        P8 VCT; f32x16 bvv;
#pragma unroll
        for (int g = 0; g < 4; ++g) { const int cl0 = 32 * ct + 8 * g + 4 * lh;
            const u32x2_t vc = *(const LAS u32x2_t*)(S2 + (r + 1) * STG_PITCH + cl0 * 2), vp = *(const LAS u32x2_t*)(S2 + r * STG_PITCH + cl0 * 2);
            const f32x4 muv = *(const LAS f32x4*)(pt + PT_MU + 1024 + hd * 64 + cl0);
            const float v0 = bflo(vc.x), v1 = bfhi(vc.x), v2 = bflo(vc.y), v3 = bfhi(vc.y), q0 = bflo(vp.x), q1 = bfhi(vp.x), q2 = bflo(vp.y), q3 = bfhi(vp.y);
            const float s0 = v0 + (q0 - v0) * muv[0], s1 = v1 + (q1 - v1) * muv[1], s2 = v2 + (q2 - v2) * muv[2], s3 = v3 + (q3 - v3) * muv[3];
            VCT.w[2 * g] = cvtpk(s0, s1); VCT.w[2 * g + 1] = cvtpk(s2, s3);
            bvv[4 * g] = s0 * bon; bvv[4 * g + 1] = s1 * bon; bvv[4 * g + 2] = s2 * bon; bvv[4 * g + 3] = s3 * bon; }
        { const P8 p = pack_tile(bvv); GAS u32x4_t* dst = (GAS u32x4_t*)(B.bv + (size_t)unit * (RW_BV_BYTES / 2) + (size_t)(ct * 64 + lane) * 16);
          dst[0] = (u32x4_t){p.w[0], p.w[1], p.w[2], p.w[3]}; dst[1] = (u32x4_t){p.w[4], p.w[5], p.w[6], p.w[7]}; }
        VC[ct] = pack_tile(mm1(VCT, If, zero16()));
        f32x16 bh = unpack_tile(BCT[ct]), kh = unpack_tile(KCT[ct]);
#pragma unroll
        for (int g = 0; g < 4; ++g) { const f32x4 cc = *(const LAS f32x4*)(cumc + 32 * ct + 8 * g + 4 * lh);
#pragma unroll
            for (int e = 0; e < 4; ++e) { const float gm = __expf(cc[e]); bh[4 * g + e] *= gm; kh[4 * g + e] *= gm; } }
        BhC[ct] = pack_tile(mm1(pack_tile(bh), If, zero16())); KhC[ct] = pack_tile(mm1(pack_tile(kh), If, zero16()));
        asm volatile("" ::: "memory"); }
    P8 UC[2], WC[2];
#pragma unroll
    for (int ct = 0; ct < 2; ++ct) { const P8 X1 = pack_tile(mm1(Aak, VC[ct], zero16())); UC[ct] = pack_tile(mm1(XT, X1, zero16())); WC[ct] = pack_tile(mm1(XT, AC[ct], zero16())); }
    { bf16* mfp = B.mf + (size_t)unit * (RW_MF_BYTES / 2);
#pragma unroll
      for (int cpt = 0; cpt < 2; ++cpt)
#pragma unroll
          for (int ct = 0; ct < 2; ++ct) { f32x16 acc = mm1(WC[cpt], BhC[ct], zero16());
              if (cpt == ct) { const float gm = ct ? gam1 : gam0;
#pragma unroll
                  for (int i = 0; i < 16; ++i) acc[i] += ((i & 3) + 8 * (i >> 2) + 4 * lh == r) ? gm : 0.f; }
              const P8 p = pack_tile(acc);
              *(GAS u32x4_t*)(mfp + (size_t)(((ct * 2 + cpt) * 2 + 0) * 64 + lane) * 8) = (u32x4_t){p.w[0], p.w[1], p.w[2], p.w[3]};
              *(GAS u32x4_t*)(mfp + (size_t)(((ct * 2 + cpt) * 2 + 1) * 64 + lane) * 8) = (u32x4_t){p.w[4], p.w[5], p.w[6], p.w[7]}; } }
    { bf16* nap = B.na + (size_t)unit * (RW_NA_BYTES / 2);
#pragma unroll
      for (int ct = 0; ct < 2; ++ct)
#pragma unroll
          for (int vt = 0; vt < 2; ++vt) { f32x16 acc = mm1(BhC[ct], UC[vt], zero16()); acc = mm1(KhC[ct], VC[vt], acc);
              const P8 p = pack_tile(acc); GAS u32x4_t* dst = (GAS u32x4_t*)(nap + (size_t)((ct * 2 + vt) * 64 + lane) * 16);
              dst[0] = (u32x4_t){p.w[0], p.w[1], p.w[2], p.w[3]}; dst[1] = (u32x4_t){p.w[4], p.w[5], p.w[6], p.w[7]}; } }
    { bf16* pfp = B.pf + (size_t)unit * (RW_PF_BYTES / 2);
#pragma unroll
      for (int ct = 0; ct < 2; ++ct) { f32x16 acc = mm1(WC[ct], Arb, unpack_tile(RCT[ct]));
          const P8 p = pack_tile(acc);
          *(GAS u32x4_t*)(pfp + (size_t)((ct * 2 + 0) * 64 + lane) * 8) = (u32x4_t){p.w[0], p.w[1], p.w[2], p.w[3]};
          *(GAS u32x4_t*)(pfp + (size_t)((ct * 2 + 1) * 64 + lane) * 8) = (u32x4_t){p.w[4], p.w[5], p.w[6], p.w[7]}; } }
    { bf16* qap = B.qa + (size_t)unit * (RW_QA_BYTES / 2);
#pragma unroll
      for (int vt = 0; vt < 2; ++vt) { f32x16 acc = mm1(UC[vt], Arb, zero16()); acc = mm1(VC[vt], Ark, acc);
          const P8 p = pack_tile(acc); GAS u32x4_t* dst = (GAS u32x4_t*)(qap + (size_t)(vt * 64 + lane) * 16);
          dst[0] = (u32x4_t){p.w[0], p.w[1], p.w[2], p.w[3]}; dst[1] = (u32x4_t){p.w[4], p.w[5], p.w[6], p.w[7]}; } }
    LDS_WAIT(); asm volatile("" ::: "memory");
}

struct SeqIn { u32x4_t mf[8]; u32x4_t na[2][2]; u32x4_t pf[4]; u32x4_t qa[2]; };
__device__ __forceinline__ void seq_load(SeqIn& s, const RwkvBufs& B, int unit, int vt, int lane) {
    const bf16* mfp = B.mf + (size_t)unit * (RW_MF_BYTES / 2);
#pragma unroll
    for (int f = 0; f < 8; ++f) s.mf[f] = *(const GAS u32x4_t*)(mfp + (size_t)(f * 64 + lane) * 8);
    const bf16* nap = B.na + (size_t)unit * (RW_NA_BYTES / 2);
#pragma unroll
    for (int ct = 0; ct < 2; ++ct) { const GAS u32x4_t* p = (const GAS u32x4_t*)(nap + (size_t)((ct * 2 + vt) * 64 + lane) * 16); s.na[ct][0] = p[0]; s.na[ct][1] = p[1]; }
    const bf16* pfp = B.pf + (size_t)unit * (RW_PF_BYTES / 2);
#pragma unroll
    for (int f = 0; f < 4; ++f) s.pf[f] = *(const GAS u32x4_t*)(pfp + (size_t)(f * 64 + lane) * 8);
    const GAS u32x4_t* q = (const GAS u32x4_t*)(B.qa + (size_t)unit * (RW_QA_BYTES / 2) + (size_t)(vt * 64 + lane) * 16); s.qa[0] = q[0]; s.qa[1] = q[1];
}
__device__ __forceinline__ f32x16 unpack2(const u32x4_t& a, const u32x4_t& b) { P8 p; p.w[0] = a[0]; p.w[1] = a[1]; p.w[2] = a[2]; p.w[3] = a[3]; p.w[4] = b[0]; p.w[5] = b[1]; p.w[6] = b[2]; p.w[7] = b[3]; return unpack_tile(p); }
__device__ __forceinline__ void rwkv_seq_wave(const RwkvBufs& B, int bh, int vt, int lane) {
    f32x16 H[2] = {zero16(), zero16()};
    SeqIn cur, nxt;
    seq_load(cur, B, bh * 128, vt, lane);
    for (int c = 0; c < 128; ++c) {
        const int unit = bh * 128 + c;
        if (c + 1 < 128) seq_load(nxt, B, unit + 1, vt, lane);
        const P8 HP0 = pack_tile(H[0]), HP1 = pack_tile(H[1]);
        f32x16 yt = unpack2(cur.qa[0], cur.qa[1]);
        yt = MFMA32(frag<0>(HP0), __builtin_bit_cast(bf16x8_t, cur.pf[0]), yt); yt = MFMA32(frag<1>(HP0), __builtin_bit_cast(bf16x8_t, cur.pf[1]), yt);
        yt = MFMA32(frag<0>(HP1), __builtin_bit_cast(bf16x8_t, cur.pf[2]), yt); yt = MFMA32(frag<1>(HP1), __builtin_bit_cast(bf16x8_t, cur.pf[3]), yt);
        f32x16 hn[2];
#pragma unroll
        for (int ct = 0; ct < 2; ++ct) { f32x16 acc = unpack2(cur.na[ct][0], cur.na[ct][1]);
            acc = MFMA32(__builtin_bit_cast(bf16x8_t, cur.mf[(ct * 2 + 0) * 2 + 0]), frag<0>(HP0), acc); acc = MFMA32(__builtin_bit_cast(bf16x8_t, cur.mf[(ct * 2 + 0) * 2 + 1]), frag<1>(HP0), acc);
            acc = MFMA32(__builtin_bit_cast(bf16x8_t, cur.mf[(ct * 2 + 1) * 2 + 0]), frag<0>(HP1), acc); acc = MFMA32(__builtin_bit_cast(bf16x8_t, cur.mf[(ct * 2 + 1) * 2 + 1]), frag<1>(HP1), acc);
            hn[ct] = acc; }
        H[0] = hn[0]; H[1] = hn[1];
        const P8 yp = pack_tile(yt);
        GAS u32x4_t* q = (GAS u32x4_t*)(B.qa + (size_t)unit * (RW_QA_BYTES / 2) + (size_t)(vt * 64 + lane) * 16);
        q[0] = (u32x4_t){yp.w[0], yp.w[1], yp.w[2], yp.w[3]}; q[1] = (u32x4_t){yp.w[4], yp.w[5], yp.w[6], yp.w[7]};
        cur = nxt;
    }
}

__device__ __forceinline__ void rwkv_post_unit(const RwkvBufs& B, const bf16* gates, const float* lnw, const float* lnb, bf16* ybuf, int unit, int lane) {
    const int r = lane & 31, lh = lane >> 5;
    const int c = unit & 127, hd = (unit >> 7) & 7, b = unit >> 10;
    const size_t m = (size_t)b * SEQ + c * 32 + r;
    f32x16 y[2], bvv[2];
#pragma unroll
    for (int vt = 0; vt < 2; ++vt) { const GAS u32x4_t* q = (const GAS u32x4_t*)(B.qa + (size_t)unit * (RW_QA_BYTES / 2) + (size_t)(vt * 64 + lane) * 16); const u32x4_t q0 = q[0], q1 = q[1]; y[vt] = unpack2(q0, q1);
        const GAS u32x4_t* p = (const GAS u32x4_t*)(B.bv + (size_t)unit * (RW_BV_BYTES / 2) + (size_t)(vt * 64 + lane) * 16); const u32x4_t p0 = p[0], p1 = p[1]; bvv[vt] = unpack2(p0, p1); }
    float s = 0.f;
#pragma unroll
    for (int vt = 0; vt < 2; ++vt)
#pragma unroll
        for (int i = 0; i < 16; ++i) s += y[vt][i];
    s += __shfl_xor(s, 32); const float mean = s * (1.f / 64.f);
    float q2 = 0.f;
#pragma unroll
    for (int vt = 0; vt < 2; ++vt)
#pragma unroll
        for (int i = 0; i < 16; ++i) { const float d = y[vt][i] - mean; q2 += d * d; }
    q2 += __shfl_xor(q2, 32); const float rstd = 1.f / sqrtf(q2 * (1.f / 64.f) + GN_EPS);
#pragma unroll
    for (int vt = 0; vt < 2; ++vt)
#pragma unroll
        for (int g = 0; g < 4; ++g) { const int ch0 = hd * 64 + 32 * vt + 8 * g + 4 * lh;
            const f32x4 lw = *(const GAS f32x4*)(lnw + ch0), lb = *(const GAS f32x4*)(lnb + ch0);
            const u32x2_t gt = *(const GAS u32x2_t*)(gates + m * 1024 + ch0);
            const float gg[4] = {bflo(gt.x), bfhi(gt.x), bflo(gt.y), bfhi(gt.y)}; float o[4];
#pragma unroll
            for (int e = 0; e < 4; ++e) { const int i = 4 * g + e; const float v = (y[vt][i] - mean) * rstd * lw[e] + lb[e] + bvv[vt][i]; o[e] = v * gg[e] * __builtin_amdgcn_rcpf(1.f + __expf(-gg[e])); }
            u32x2_t w; w.x = cvtpk(o[0], o[1]); w.y = cvtpk(o[2], o[3]);
            *(GAS u32x2_t*)(ybuf + m * DM + ch0) = w; }
}

constexpr float LOG2E = 1.4426950408889634f;
constexpr int MB_KF = 0, MB_VF = 32768, MB_LIST = 65536, MB_CNT = 65536 + 8192;
struct MobaBufs { const bf16* qkva; const float* kmean; unsigned* sel; bf16* part; float* ml; const bf16* gates; bf16* ybuf; };

__device__ __forceinline__ void moba_gate_unit(const MobaBufs& M, int unit, LAS unsigned char* lds, int tid) {
    const int bh = unit >> 3, ck = unit & 7, b = bh >> 3, h = bh & 7;
    LAS float* km = (LAS float*)lds;
    __syncthreads();
    for (int i = tid; i < 1024; i += 512) km[i] = M.kmean[(size_t)bh * 1024 + i];
    __syncthreads();
    const int t = ck * 512 + tid, qb = t >> 8;
    const bf16* qp = M.qkva + ((size_t)b * SEQ + t) * 1536 + h * 64;
    float q[64];
#pragma unroll
    for (int c8 = 0; c8 < 8; ++c8) { const v4u v = *(const GAS v4u*)(qp + c8 * 8);
        q[c8 * 8 + 0] = bflo(v.x); q[c8 * 8 + 1] = bfhi(v.x); q[c8 * 8 + 2] = bflo(v.y); q[c8 * 8 + 3] = bfhi(v.y);
        q[c8 * 8 + 4] = bflo(v.z); q[c8 * 8 + 5] = bfhi(v.z); q[c8 * 8 + 6] = bflo(v.w); q[c8 * 8 + 7] = bfhi(v.w); }
    float g0 = -3e38f, g1 = -3e38f, g2 = -3e38f; unsigned i0 = 0xffu, i1 = 0xffu, i2 = 0xffu;
    for (int n = 0; n < qb; ++n) { float g = 0.f;
#pragma unroll
        for (int d4 = 0; d4 < 16; ++d4) { const f32x4 kv = *(const LAS f32x4*)(km + n * 64 + d4 * 4);
            g += q[d4 * 4] * kv[0] + q[d4 * 4 + 1] * kv[1] + q[d4 * 4 + 2] * kv[2] + q[d4 * 4 + 3] * kv[3]; }
        if (g > g0) { g2 = g1; i2 = i1; g1 = g0; i1 = i0; g0 = g; i0 = (unsigned)n; }
        else if (g > g1) { g2 = g1; i2 = i1; g1 = g; i1 = (unsigned)n; }
        else if (g > g2) { g2 = g; i2 = (unsigned)n; } }
    M.sel[(size_t)bh * SEQ + t] = i0 | (i1 << 8) | (i2 << 16);
}

__device__ __forceinline__ void moba_stage_kv(const MobaBufs& M, size_t kvrow0, int h, LAS unsigned char* lds, int wave, int lane) {
    const int r = lane & 31, lh = lane >> 5;
    const bf16* kp = M.qkva + (kvrow0 + 32 * wave + r) * 1536 + 512 + h * 64;
#pragma unroll
    for (int s = 0; s < 4; ++s) { const v4u v = *(const GAS v4u*)(kp + 16 * s + 8 * lh); *(LAS v4u*)(lds + MB_KF + ((wave * 4 + s) * 64 + lane) * 16) = v; }
    const bf16* vp = M.qkva + (kvrow0 + 32 * wave + r) * 1536 + 1024 + h * 64;
    P8 If;
#pragma unroll
    for (int q = 0; q < 8; ++q) { const int i0 = 2 * q, i1 = 2 * q + 1;
        const unsigned lo = ((i0 & 3) + 8 * (i0 >> 2) + 4 * lh == r) ? 0x3f80u : 0u, hi = ((i1 & 3) + 8 * (i1 >> 2) + 4 * lh == r) ? 0x3f800000u : 0u; If.w[q] = lo | hi; }
#pragma unroll
    for (int dt = 0; dt < 2; ++dt) { P8 vct;
#pragma unroll
        for (int g = 0; g < 4; ++g) { const u32x2_t v = *(const GAS u32x2_t*)(vp + 32 * dt + 8 * g + 4 * lh); vct.w[2 * g] = v.x; vct.w[2 * g + 1] = v.y; }
        const P8 vc = pack_tile(mm1(vct, If, zero16()));
        *(LAS u32x4_t*)(lds + MB_VF + (((wave * 2 + dt) * 2 + 0) * 64 + lane) * 16) = (u32x4_t){vc.w[0], vc.w[1], vc.w[2], vc.w[3]};
        *(LAS u32x4_t*)(lds + MB_VF + (((wave * 2 + dt) * 2 + 1) * 64 + lane) * 16) = (u32x4_t){vc.w[4], vc.w[5], vc.w[6], vc.w[7]}; }
}

template <bool CAUSAL> __device__ __forceinline__ void moba_scores(f32x16 (&St)[8], const bf16x8_t (&Qf)[4], LAS unsigned char* lds, int nkt, float slope2, float cq, int lim, int lane) {
    const int lh = lane >> 5;
#pragma unroll
    for (int kt = 0; kt < 8; ++kt) {
        if (kt < nkt) { f32x16 acc = zero16();
#pragma unroll
            for (int s = 0; s < 4; ++s) { const bf16x8_t kf = *(const LAS bf16x8_t*)(lds + MB_KF + ((kt * 4 + s) * 64 + lane) * 16); acc = MFMA32(kf, Qf[s], acc); }
#pragma unroll
            for (int i = 0; i < 16; ++i) { const int key = 32 * kt + (i & 3) + 8 * (i >> 2) + 4 * lh;
                float v = acc[i] * (0.125f * LOG2E) + (slope2 * (float)key + cq);
                if (CAUSAL) v = (key <= lim) ? v : -INFINITY;
                acc[i] = v; }
            St[kt] = acc; asm volatile("" ::: "memory"); }
        else {
#pragma unroll
            for (int i = 0; i < 16; ++i) St[kt][i] = -INFINITY; }
    }
}

__device__ __forceinline__ void moba_sel_unit(const MobaBufs& M, int unit, LAS unsigned char* lds, int tid, int lane_in, int wave) {
    int lane = lane_in; asm volatile("" : "+v"(lane));
    const int n = unit >> 6, bh = unit & 63, b = bh >> 3, h = bh & 7;
    const int r = lane & 31, lh = lane >> 5;
    LAS unsigned short* list = (LAS unsigned short*)(lds + MB_LIST); LAS unsigned* cntp = (LAS unsigned*)(lds + MB_CNT);
    __syncthreads();
    if (tid == 0) *cntp = 0u;
    __syncthreads();
    for (int t = 256 * (n + 1) + tid; t < SEQ; t += 512) { const unsigned s = M.sel[(size_t)bh * SEQ + t];
        const unsigned b0 = s & 0xffu, b1 = (s >> 8) & 0xffu, b2 = (s >> 16) & 0xffu;
        if (b0 == (unsigned)n || b1 == (unsigned)n || b2 == (unsigned)n) { const unsigned slot = (b0 == (unsigned)n) ? 0u : ((b1 == (unsigned)n) ? 1u : 2u);
            const unsigned idx = __hip_atomic_fetch_add(cntp, 1u, __ATOMIC_RELAXED, __HIP_MEMORY_SCOPE_WORKGROUP); list[idx] = (unsigned short)(t | (slot << 12)); } }
    moba_stage_kv(M, (size_t)b * SEQ + 256 * n, h, lds, wave, lane);
    __syncthreads();
    const int cnt = (int)*cntp;
    const float slope = exp2f(-(float)(h + 1)), slope2 = slope * LOG2E;
    for (int base = 0; base < cnt; base += 256) {
        const int qi = base + 32 * wave + r; const bool valid = qi < cnt;
        if (base + 32 * wave >= cnt) continue;
        const unsigned ent = list[valid ? qi : base + 32 * wave]; const int t = ent & 0xfff, slot = ent >> 12;
        const bf16* qp = M.qkva + ((size_t)b * SEQ + t) * 1536 + h * 64;
        bf16x8_t Qf[4];
#pragma unroll
        for (int s = 0; s < 4; ++s) Qf[s] = *(const GAS bf16x8_t*)(qp + 16 * s + 8 * lh);
        f32x16 St[8];
        float sl2 = slope2; int ln2 = lane; asm volatile("" : "+v"(sl2), "+v"(ln2));
        moba_scores<false>(St, Qf, lds, 8, sl2, sl2 * (float)(256 * n - t), 255, ln2);
        float mx = -INFINITY;
#pragma unroll
        for (int kt = 0; kt < 8; ++kt)
#pragma unroll
            for (int i = 0; i < 16; ++i) mx = fmaxf(mx, St[kt][i]);
        mx = fmaxf(mx, __shfl_xor(mx, 32));
        float ls = 0.f; f32x16 O[2] = {zero16(), zero16()};
#pragma unroll
        for (int kt = 0; kt < 8; ++kt) {
#pragma unroll
            for (int i = 0; i < 16; ++i) { const float p = __builtin_amdgcn_exp2f(St[kt][i] - mx); St[kt][i] = p; ls += p; }
            const P8 pp = pack_tile(St[kt]);
#pragma unroll
            for (int dt = 0; dt < 2; ++dt) {
                const bf16x8_t v0 = *(const LAS bf16x8_t*)(lds + MB_VF + (((kt * 2 + dt) * 2 + 0) * 64 + lane) * 16), v1 = *(const LAS bf16x8_t*)(lds + MB_VF + (((kt * 2 + dt) * 2 + 1) * 64 + lane) * 16);
                O[dt] = MFMA32(v0, frag<0>(pp), O[dt]); O[dt] = MFMA32(v1, frag<1>(pp), O[dt]); }
            asm volatile("" ::: "memory"); }
        ls += __shfl_xor(ls, 32);
        const float inv = 1.f / ls;
        if (valid) {
            bf16* rec = M.part + (((size_t)bh * SEQ + t) * 3 + slot) * 64;
#pragma unroll
            for (int dt = 0; dt < 2; ++dt)
#pragma unroll
                for (int g = 0; g < 4; ++g) { u32x2_t w; w.x = cvtpk(O[dt][4 * g] * inv, O[dt][4 * g + 1] * inv); w.y = cvtpk(O[dt][4 * g + 2] * inv, O[dt][4 * g + 3] * inv);
                    *(GAS u32x2_t*)(rec + 32 * dt + 8 * g + 4 * lh) = w; }
            if (lh == 0) { float* mlp = M.ml + (((size_t)bh * SEQ + t) * 3 + slot) * 2; mlp[0] = mx; mlp[1] = ls; }
        }
    }
}

__device__ __forceinline__ void moba_own_unit(const MobaBufs& M, int unit, LAS unsigned char* lds, int tid, int lane_in, int wave) {
    int lane = lane_in; asm volatile("" : "+v"(lane));
    const int qb = unit & 15, bh = unit >> 4, b = bh >> 3, h = bh & 7;
    const int r = lane & 31, lh = lane >> 5;
    __syncthreads();
    moba_stage_kv(M, (size_t)b * SEQ + 256 * qb, h, lds, wave, lane);
    __syncthreads();
    const float slope = exp2f(-(float)(h + 1)), slope2 = slope * LOG2E;
    const int tl = 32 * wave + r, t = 256 * qb + tl;
    const bf16* qp = M.qkva + ((size_t)b * SEQ + t) * 1536 + h * 64;
    bf16x8_t Qf[4];
#pragma unroll
    for (int s = 0; s < 4; ++s) Qf[s] = *(const GAS bf16x8_t*)(qp + 16 * s + 8 * lh);
    f32x16 St[8];
    moba_scores<true>(St, Qf, lds, wave + 1, slope2, -slope2 * (float)tl, tl, lane);
    float mx = -INFINITY;
#pragma unroll
    for (int kt = 0; kt < 8; ++kt)
#pragma unroll
        for (int i = 0; i < 16; ++i) mx = fmaxf(mx, St[kt][i]);
    mx = fmaxf(mx, __shfl_xor(mx, 32));
    const int nv = qb < 3 ? qb : 3;
    float ms[3], lsv[3]; float M2 = mx;
#pragma unroll
    for (int j = 0; j < 3; ++j) { ms[j] = -INFINITY; lsv[j] = 0.f;
        if (j < nv) { const float* mlp = M.ml + (((size_t)bh * SEQ + t) * 3 + j) * 2; ms[j] = mlp[0]; lsv[j] = mlp[1]; M2 = fmaxf(M2, ms[j]); } }
    float ls = 0.f; f32x16 O[2] = {zero16(), zero16()};
#pragma unroll
    for (int kt = 0; kt < 8; ++kt) {
        if (kt <= wave) {
#pragma unroll
            for (int i = 0; i < 16; ++i) { const float p = __builtin_amdgcn_exp2f(St[kt][i] - M2); St[kt][i] = p; ls += p; }
            const P8 pp = pack_tile(St[kt]);
#pragma unroll
            for (int dt = 0; dt < 2; ++dt) {
                const bf16x8_t v0 = *(const LAS bf16x8_t*)(lds + MB_VF + (((kt * 2 + dt) * 2 + 0) * 64 + lane) * 16), v1 = *(const LAS bf16x8_t*)(lds + MB_VF + (((kt * 2 + dt) * 2 + 1) * 64 + lane) * 16);
                O[dt] = MFMA32(v0, frag<0>(pp), O[dt]); O[dt] = MFMA32(v1, frag<1>(pp), O[dt]); }
            asm volatile("" ::: "memory"); }
    }
    ls += __shfl_xor(ls, 32);
#pragma unroll
    for (int j = 0; j < 3; ++j) {
        if (j < nv) { const float wj = lsv[j] * __builtin_amdgcn_exp2f(ms[j] - M2); ls += wj;
            const bf16* rec = M.part + (((size_t)bh * SEQ + t) * 3 + j) * 64;
#pragma unroll
            for (int dt = 0; dt < 2; ++dt)
#pragma unroll
                for (int g = 0; g < 4; ++g) { const u32x2_t w = *(const GAS u32x2_t*)(rec + 32 * dt + 8 * g + 4 * lh);
                    O[dt][4 * g] += wj * bflo(w.x); O[dt][4 * g + 1] += wj * bfhi(w.x); O[dt][4 * g + 2] += wj * bflo(w.y); O[dt][4 * g + 3] += wj * bfhi(w.y); } } }
    const float inv = 1.f / ls;
    const bf16* gp = M.gates + ((size_t)b * SEQ + t) * 1024 + 512 + h * 64;
    bf16* yp = M.ybuf + ((size_t)b * SEQ + t) * DM + 512 + h * 64;
#pragma unroll
    for (int dt = 0; dt < 2; ++dt)
#pragma unroll
        for (int g = 0; g < 4; ++g) { const u32x2_t gw = *(const GAS u32x2_t*)(gp + 32 * dt + 8 * g + 4 * lh);
            const float gg[4] = {bflo(gw.x), bfhi(gw.x), bflo(gw.y), bfhi(gw.y)}; float o[4];
#pragma unroll
            for (int e = 0; e < 4; ++e) o[e] = O[dt][4 * g + e] * inv * gg[e] * __builtin_amdgcn_rcpf(1.f + __expf(-gg[e]));
            u32x2_t w; w.x = cvtpk(o[0], o[1]); w.y = cvtpk(o[2], o[3]);
            *(GAS u32x2_t*)(yp + 32 * dt + 8 * g + 4 * lh) = w; }
}

__device__ __forceinline__ void phase_wdad(const Args& a, int tid) {
    const bf16* src = (const bf16*)(a.ws + WS_WDAD); bf16* dst = (bf16*)(a.ws + WS_WDAD2); const float* mu = a.in[3] + 1536;
    for (int it = blockIdx.x * 512 + tid; it < MTOK * 16; it += gridDim.x * 512) {
        const int m = it >> 4, ch = it & 15, t = m % SEQ;
        const v4u cv = *(const GAS v4u*)(src + (size_t)m * 128 + ch * 8); v4u pv = {0u, 0u, 0u, 0u};
        if (t > 0) pv = *(const GAS v4u*)(src + (size_t)(m - 1) * 128 + ch * 8);
        const f32x4 m0 = *(const GAS f32x4*)(mu + ch * 8), m1 = *(const GAS f32x4*)(mu + ch * 8 + 4);
        float o[8];
#pragma unroll
        for (int q = 0; q < 4; ++q) { const unsigned cw = cv[q], pw = pv[q];
            const float c0 = bflo(cw), c1 = bfhi(cw), p0 = bflo(pw), p1 = bfhi(pw);
            const float ma = (q < 2) ? m0[2 * q] : m1[2 * q - 4], mb = (q < 2) ? m0[2 * q + 1] : m1[2 * q - 3];
            o[2 * q] = c0 + (p0 - c0) * ma; o[2 * q + 1] = c1 + (p1 - c1) * mb; }
        if (ch < 8) {
#pragma unroll
            for (int q = 0; q < 8; ++q) o[q] = 1.f - 2.f * __builtin_amdgcn_rcpf(1.f + __expf(2.f * o[q]));
        }
        v4u ov = {cvtpk(o[0], o[1]), cvtpk(o[2], o[3]), cvtpk(o[4], o[5]), cvtpk(o[6], o[7])};
        *(GAS v4u*)(dst + (size_t)m * 128 + ch * 8) = ov;
    }
}

struct EpiSplit {
    static constexpr bool PERM = true, AFTER_DRAIN = false;
    bf16 *rkv, *qkva, *gates, *wdad;
    __device__ __forceinline__ void operator()(const pg8::f32x4 (&acc)[2][2][4][2], const pg8::Unit& u, int wr, int wc, int fr, int fq) const {
        const int pn = u.pn; bf16* base; int ldc, colt;
        if (pn < 6) { base = rkv; ldc = 1536; colt = pn * 256; } else if (pn < 12) { base = qkva; ldc = 1536; colt = (pn - 6) * 256; }
        else if (pn < 16) { base = gates; ldc = 1024; colt = (pn - 12) * 256; } else { base = wdad; ldc = 128; colt = 0; }
        const int row0 = u.pm * pg8::BM + wr * 64 + fr, col0 = colt + wc * 32 + 8 * fq;
#pragma unroll
        for (int ai = 0; ai < 2; ++ai)
#pragma unroll
            for (int m = 0; m < 4; ++m) { bf16* rowp = base + (size_t)(row0 + ai * pg8::HALF + m * 16) * ldc + col0;
#pragma unroll
                for (int bj = 0; bj < 2; ++bj) { if (pn == 16 && bj == 1) continue;
                    const pg8::f32x4 v0 = acc[ai][bj][m][0], v1 = acc[ai][bj][m][1];
                    pg8::u32x4 w; w.x = pg8::cvt_pk_bf16(v0[0], v0[1]); w.y = pg8::cvt_pk_bf16(v0[2], v0[3]); w.z = pg8::cvt_pk_bf16(v1[0], v1[1]); w.w = pg8::cvt_pk_bf16(v1[2], v1[3]);
                    *(pg8::u32x4*)(rowp + bj * pg8::HALF) = w; } }
    }
};
__global__ void __launch_bounds__(NWAVES * 64, 2) k_fused(Args a) {
    extern __shared__ __attribute__((aligned(16))) unsigned char lds_raw[];
    LAS unsigned char* lds = (LAS unsigned char*)lds_raw;
    volatile LAS unsigned* MISC = (volatile LAS unsigned*)(lds + MISC_OFF);
    const int tid = threadIdx.x, lane = tid & 63, wave = __builtin_amdgcn_readfirstlane(tid >> 6);
    gu32* ctl = (gu32*)(a.ws + WS_CTL);
    for (int u = tid; u < (LDS_BYTES - LDSCTL_OFF) / 4; u += NWAVES * 64) ((LAS unsigned*)(lds + LDSCTL_OFF))[u] = 0u;
    __syncthreads();
    XcdBarrier bar = xcd_barrier_post((unsigned*)(ctl + CW_BAR), MISC + 8);

    phase_prologue(a, lds, tid, lane, wave);
    xcd_barrier(bar);
    {
        pg8::Gemm g{(const pg8::bf16_t*)(a.ws + WS_XN), (const pg8::bf16_t*)(a.ws + WS_WIN), MTOK, NPROJ_PAD, DM};
        pg8::StaticOrder S; S.init(MTOK, NPROJ_PAD, gridDim.x, (int)blockIdx.x);
        EpiSplit E{(bf16*)(a.ws + WS_RKV), (bf16*)(a.ws + WS_QKVA), (bf16*)(a.ws + WS_GATES), (bf16*)(a.ws + WS_WDAD)};
        pg8::gemm_phase<EpiSplit, pg8::StaticOrder, true, true>(lds + RING_OFF, g, S, E);
    }
    xcd_barrier(bar);
    phase_kmean(a, tid);
    phase_wdad(a, tid);
    xcd_barrier(bar);
    RwkvBufs RB{(const bf16*)(a.ws + WS_RKV), (const bf16*)(a.ws + WS_WDAD2), (bf16*)(a.ws + WS_MF), (bf16*)(a.ws + WS_NA), (bf16*)(a.ws + WS_PF), (bf16*)(a.ws + WS_QA), (bf16*)(a.ws + WS_BV),
                (const bf16*)(a.ws + WS_W2T), (const bf16*)(a.ws + WS_A2T)};
    MobaBufs MB{(const bf16*)(a.ws + WS_QKVA), (const float*)(a.ws + WS_KMEAN), (unsigned*)(a.ws + WS_SEL), (bf16*)(a.ws + WS_PART), (float*)(a.ws + WS_ML), (const bf16*)(a.ws + WS_GATES), (bf16*)(a.ws + WS_YBUF)};
    {
        for (int u = blockIdx.x; u < BATCH * NH * 8; u += gridDim.x) moba_gate_unit(MB, u, lds + RING_OFF, tid);
        __syncthreads();
        LAS float* pt = (LAS float*)(lds + RING_OFF);
        for (int i = tid; i < PT_FLOATS; i += NWAVES * 64) { float v;
            if (i < PT_W0) v = a.in[3][i]; else if (i < PT_A0) v = a.in[4][i - PT_W0]; else if (i < PT_KK) v = a.in[6][i - PT_A0]; else if (i < PT_KA) v = a.in[8][i - PT_KK];
            else if (i < PT_RK) v = a.in[9][i - PT_KA]; else v = a.in[10][i - PT_RK];
            pt[i] = v; }
        __syncthreads();
        LAS unsigned char* wl = lds + RING_OFF + PREP_PT_BYTES + wave * PREP_WAVE_BYTES;
        for (int u = blockIdx.x * NWAVES + wave; u < RW_NUNITS; u += gridDim.x * NWAVES) rwkv_prep_unit(RB, u, wl, pt, lane);
    }
    xcd_barrier(bar);
    {
        if (blockIdx.x < 16) { const int item = blockIdx.x * NWAVES + wave; rwkv_seq_wave(RB, item >> 1, item & 1, lane); }
        LAS unsigned* qslot = (LAS unsigned*)(lds + RING_OFF + MB_CNT + 64);
        for (;;) {
            __syncthreads();
            if (tid == 0) *qslot = __hip_atomic_fetch_add((unsigned*)(ctl + CW_QUEUE), 1u, __ATOMIC_RELAXED, __HIP_MEMORY_SCOPE_AGENT);
            __syncthreads();
            const unsigned u = *qslot;
            if (u >= (unsigned)(15 * BATCH * NH)) break;
            moba_sel_unit(MB, (int)u, lds + RING_OFF, tid, lane, wave);
        }
    }
    xcd_barrier(bar);
    for (int u = blockIdx.x * NWAVES + wave; u < RW_NUNITS; u += gridDim.x * NWAVES)
        rwkv_post_unit(RB, (const bf16*)(a.ws + WS_GATES), a.in[11], a.in[12], (bf16*)(a.ws + WS_YBUF), u, lane);
    for (int u = blockIdx.x; u < BATCH * NH * 16; u += gridDim.x) moba_own_unit(MB, u, lds + RING_OFF, tid, lane, wave);
    xcd_barrier(bar);
    {
        pg8::Gemm g{(const pg8::bf16_t*)(a.ws + WS_YBUF), (const pg8::bf16_t*)(a.ws + WS_WOUT), MTOK, DM, DM};
        pg8::StaticOrder S; S.init(MTOK, DM, gridDim.x, (int)blockIdx.x);
        pg8::EpiF32 E{(float*)(a.ws + WS_OBUF), DM, nullptr};
        pg8::gemm_phase<pg8::EpiF32, pg8::StaticOrder, true, true>(lds + RING_OFF, g, S, E);
    }
    xcd_barrier(bar);
    phase_final(a, lane, wave);
}

extern "C" void kernel_launch(void* const* d_in, const int* in_sizes, int n_in, void* d_out, int out_size, void* d_ws, size_t ws_size, hipStream_t stream) {
    static int grid = 0;
    if (grid == 0) {
        if (n_in != 15 || in_sizes[0] != MTOK * DM || out_size != MTOK * DM || ws_size < WS_END) { fprintf(stderr, "kernel_launch: bad shapes n_in %d in0 %d out %d ws %zu\n", n_in, n_in > 0 ? in_sizes[0] : -1, out_size, ws_size); grid = -1; return; }
        int dev = 0, cus = 0, per_cu = 0;
        if (hipGetDevice(&dev) != hipSuccess || hipDeviceGetAttribute(&cus, hipDeviceAttributeMultiprocessorCount, dev) != hipSuccess) { grid = -1; return; }
        if (hipFuncSetAttribute((const void*)k_fused, hipFuncAttributeMaxDynamicSharedMemorySize, LDS_BYTES) != hipSuccess) { grid = -1; return; }
        if (hipOccupancyMaxActiveBlocksPerMultiprocessor(&per_cu, (const void*)k_fused, NWAVES * 64, LDS_BYTES) != hipSuccess || per_cu < 1) { fprintf(stderr, "kernel_launch: occupancy query says %d\n", per_cu); }
        (void)hipGetLastError();
        grid = cus;
    }
    if (grid < 0) return;
    if (hipMemsetAsync((char*)d_ws + WS_CTL, 0, CTL_ZERO_BYTES, stream) != hipSuccess) return;
    Args a{};
    for (int i = 0; i < 15; ++i) a.in[i] = (const float*)d_in[i];
    a.out = (float*)d_out; a.ws = (unsigned char*)d_ws;
    hipLaunchKernelGGL(k_fused, dim3(grid), dim3(NWAVES * 64), LDS_BYTES, stream, a);
}
```

```cpp
#include <hip/hip_runtime.h>
#include <cstdio>
#include <cstdint>
#include <cmath>
#ifndef PROBE_REP
#define PROBE_REP (-1)
#endif
namespace pg8 {
#define PG8_LAS __attribute__((address_space(3)))
typedef unsigned short bf16_t;
typedef short bf16x8 __attribute__((ext_vector_type(8)));
typedef float f32x4 __attribute__((ext_vector_type(4)));
typedef unsigned u32x4 __attribute__((ext_vector_type(4)));
constexpr int BM = 256, BK = 64, HALF = 128, HTB = HALF * BK * 2  , STAGE_BYTES = 8 * HTB, NXCD = 8, WGM = 8;

__host__ __device__ __forceinline__ int lds_byte(int r, int c) { const int st = (r >> 4) * 2 + (c >> 5), rr = r & 15, cc = c & 31, ob = rr * 64 + cc * 2; return st * 1024 + (ob ^ (((ob >> 9) & 1) << 5)); }
__host__ __device__ __forceinline__ void stage_rc(int b, int& R, int& C) { const int st = b / 1024, sb = b % 1024, swz = sb ^ (((sb >> 9) & 1) << 5); R = (st >> 1) * 16 + swz / 64; C = (st & 1) * 32 + (swz % 64) / 2; }
__host__ __device__ __forceinline__ int perm32(int rho) { const int n = rho >> 4, i = rho & 15; return 8 * (i >> 2) + 4 * n + (i & 3); }

struct Unit { int pm, pn; };
struct Gemm { const bf16_t* A; const bf16_t* Bt; int M, N, K; };

struct StaticOrder {
    int nM, nN, nwg, G, c;
    __host__ __device__ void init(int M, int N, int G_, int c_) { nM = M / BM; nN = N / BM; nwg = nM * nN; G = G_; c = c_; }
    __host__ __device__ bool next(int i, Unit& u) const {
        const long L = (long)i * G + c; if (L >= nwg) return false;
        int wgid = (int)L; { const int q = nwg / NXCD, r = nwg % NXCD, xcd = wgid % NXCD, off = wgid / NXCD; wgid = (xcd < r ? xcd * (q + 1) : r * (q + 1) + (xcd - r) * q) + off; }
        const int nig = WGM * nN, gid = wgid / nig, fm = gid * WGM, gsz = (nM - fm) < WGM ? (nM - fm) : WGM;
        u.pm = fm + ((wgid % nig) % gsz); u.pn = (wgid % nig) / gsz; return true;
    }
    __device__ __forceinline__ void a_ready(const Unit&) const {}
    __device__ __forceinline__ void done(const Unit&) const {}
};

__device__ __forceinline__ unsigned cvt_pk_bf16(float lo, float hi) { unsigned r; asm volatile("v_cvt_pk_bf16_f32 %0, %1, %2" : "=v"(r) : "v"(lo), "v"(hi)); return r; }
typedef float f32x2 __attribute__((ext_vector_type(2)));
__device__ __forceinline__ f32x2 gelu_pk(f32x2 v) {
    const f32x2 av = __builtin_elementwise_abs(v), d = av * 0.2316418882f + 1.0f;
    f32x2 t; t.x = __builtin_amdgcn_rcpf(d.x); t.y = __builtin_amdgcn_rcpf(d.y);
    f32x2 q = t * 0.5307027145f + (-0.7265760135f); q = q * t + 0.7107068705f; q = q * t + (-0.142248368f); q = q * t + 0.127414796f; q = q * t;
    const f32x2 s = (v * v) * (-0.72134752044f);
    f32x2 e; e.x = __builtin_amdgcn_exp2f(s.x); e.y = __builtin_amdgcn_exp2f(s.y);
    const f32x2 m = v * (q * e), r = v - m;
    f32x2 o; o.x = v.x < 0.f ? m.x : r.x; o.y = v.y < 0.f ? m.y : r.y; return o;
}

template <int ACT  > struct EpiBf16 {
    static constexpr bool PERM = true, AFTER_DRAIN = false; static_assert(ACT == 0 || ACT == 1, "EpiBf16: ACT is 0 (none) or 1 (gelu_pk)");
    bf16_t* O; int ldc; const float* bias; int split_cols; size_t split_stride; float scale0;
    __device__ __forceinline__ void operator()(const f32x4 (&acc)[2][2][4][2], const Unit& u, int wr, int wc, int fr, int fq) const {
        const int row0 = u.pm * BM + wr * 64 + fr; int colt = u.pn * BM; bf16_t* base = O;
        float sc = 1.f; if (split_cols) { const int t = colt / split_cols; base += (size_t)t * split_stride; colt -= t * split_cols; if (t == 0) sc = scale0; }
        const int col0 = colt + wc * 32 + 8 * fq, bcol0 = u.pn * BM + wc * 32 + 8 * fq;
        f32x4 bv[2][2];
#pragma unroll
        for (int bj = 0; bj < 2; ++bj)
#pragma unroll
            for (int n = 0; n < 2; ++n) bv[bj][n] = bias ? *(const f32x4*)(bias + bcol0 + bj * HALF + 4 * n) : (f32x4){0.f, 0.f, 0.f, 0.f};
#pragma unroll
        for (int ai = 0; ai < 2; ++ai)
#pragma unroll
            for (int m = 0; m < 4; ++m) { bf16_t* rowp = base + (size_t)(row0 + ai * HALF + m * 16) * ldc + col0;
#pragma unroll
                for (int bj = 0; bj < 2; ++bj) { f32x4 v0 = acc[ai][bj][m][0] + bv[bj][0], v1 = acc[ai][bj][m][1] + bv[bj][1];
                    if (ACT == 1) { f32x2 a = gelu_pk((f32x2){v0[0], v0[1]}), b = gelu_pk((f32x2){v0[2], v0[3]}), c = gelu_pk((f32x2){v1[0], v1[1]}), d = gelu_pk((f32x2){v1[2], v1[3]});
                        v0 = (f32x4){a.x, a.y, b.x, b.y}; v1 = (f32x4){c.x, c.y, d.x, d.y}; }
                    v0 = v0 * sc; v1 = v1 * sc; u32x4 w; w.x = cvt_pk_bf16(v0[0], v0[1]); w.y = cvt_pk_bf16(v0[2], v0[3]); w.z = cvt_pk_bf16(v1[0], v1[1]); w.w = cvt_pk_bf16(v1[2], v1[3]);
                    *(u32x4*)(rowp + bj * HALF) = w; } }
    }
};

struct EpiF32 {
    static constexpr bool PERM = false, AFTER_DRAIN = false;
    float* C; int ldc; const float* bias;
    __device__ __forceinline__ void operator()(const f32x4 (&acc)[2][2][4][2], const Unit& u, int wr, int wc, int fr, int fq) const {
        const int row0 = u.pm * BM + wr * 64 + fr, col0 = u.pn * BM + wc * 32 + 4 * fq;
        f32x4 bv[2][2];
#pragma unroll
        for (int bj = 0; bj < 2; ++bj)
#pragma unroll
            for (int n = 0; n < 2; ++n) bv[bj][n] = bias ? *(const f32x4*)(bias + col0 + bj * HALF + n * 16) : (f32x4){0.f, 0.f, 0.f, 0.f};
#pragma unroll
        for (int ai = 0; ai < 2; ++ai)
#pragma unroll
            for (int m = 0; m < 4; ++m) { float* rowp = C + (size_t)(row0 + ai * HALF + m * 16) * ldc + col0;
#pragma unroll
                for (int bj = 0; bj < 2; ++bj)
#pragma unroll
                    for (int n = 0; n < 2; ++n) *(f32x4*)(rowp + bj * HALF + n * 16) = acc[ai][bj][m][n] + bv[bj][n]; }
    }
};

struct PanelStats {
    unsigned* xbuf;
    unsigned* cnt;
    unsigned* tmo;
    int ntn; float eps;
    unsigned code;
    __device__ __forceinline__ bool run(const f32x4 (&v)[2][2][4][2], const Unit& u, int wr, int wc, int fr, int fq, PG8_LAS unsigned char* lds, int wid, int lane) const {
        typedef float f32x2v __attribute__((ext_vector_type(2)));
        PG8_LAS f32x2v* P = (PG8_LAS f32x2v*)lds;
        PG8_LAS f32x2v* S = (PG8_LAS f32x2v*)(lds + 8192);
        PG8_LAS unsigned* flag = (PG8_LAS unsigned*)(lds + 8192 + 2048);
#pragma unroll
        for (int ai = 0; ai < 2; ++ai)
#pragma unroll
            for (int m = 0; m < 4; ++m) {
                float s = 0.f;
#pragma unroll
                for (int bj = 0; bj < 2; ++bj)
#pragma unroll
                    for (int n = 0; n < 2; ++n) { const f32x4 x = v[ai][bj][m][n]; s += (x[0] + x[1]) + (x[2] + x[3]); }
                s += __shfl_xor(s, 16); s += __shfl_xor(s, 32);
                const float mw = s * (1.0f / 64.0f); float q = 0.f;
#pragma unroll
                for (int bj = 0; bj < 2; ++bj)
#pragma unroll
                    for (int n = 0; n < 2; ++n) { const f32x4 d = v[ai][bj][m][n] - mw; q += (d[0] * d[0] + d[1] * d[1]) + (d[2] * d[2] + d[3] * d[3]); }
                q += __shfl_xor(q, 16); q += __shfl_xor(q, 32);
                if (fq == 0) P[(ai * HALF + wr * 64 + m * 16 + fr) * 4 + wc] = (f32x2v){mw, q};
            }
        asm volatile("s_waitcnt lgkmcnt(0)" ::: "memory"); __builtin_amdgcn_s_barrier(); asm volatile("" ::: "memory");
#if defined(BROKEN_EXCHANGE_NO_WAIT)
#warning BROKEN CONTROL BUILD: the row-statistics exchange does not wait; results are wrong by design
        if (blockIdx.x >= 64) { const long long t0_ = clock64(); while (clock64() - t0_ < 60000) __builtin_amdgcn_s_sleep(8); }
#endif
        const int row = wid * 32 + (lane & 31);
        if (lane < 32) {
            const f32x2v a = P[row * 4 + 0], b = P[row * 4 + 1], c = P[row * 4 + 2], d = P[row * 4 + 3];
            const float mt = (a.x + b.x + c.x + d.x) * 0.25f;
            const float da = a.x - mt, db = b.x - mt, dc = c.x - mt, dd = d.x - mt;
            const float m2 = (a.y + b.y) + (c.y + d.y) + 64.0f * ((da * da + db * db) + (dc * dc + dd * dd));
            unsigned long long* slot = (unsigned long long*)xbuf + ((size_t)(u.pm * BM + row) * 4 + u.pn);
            __hip_atomic_store(slot, ((unsigned long long)__float_as_uint(m2) << 32) | __float_as_uint(mt), __ATOMIC_RELAXED, __HIP_MEMORY_SCOPE_AGENT);
        }
        asm volatile("s_waitcnt vmcnt(0)" ::: "memory");
        if (lane == 0) __hip_atomic_fetch_add(cnt + 64 * u.pm, 1u, __ATOMIC_RELAXED, __HIP_MEMORY_SCOPE_AGENT);
        if (wid == 0) {
            bool dead = false; const unsigned long long t0 = __builtin_amdgcn_s_memrealtime(); const unsigned want = 8u * (unsigned)ntn;
            for (;;) {
#if defined(BROKEN_EXCHANGE_NO_WAIT)
                break;
#endif
                if ((unsigned)__builtin_amdgcn_readfirstlane(__hip_atomic_load(cnt + 64 * u.pm, __ATOMIC_RELAXED, __HIP_MEMORY_SCOPE_AGENT)) >= want) break;
                if (__builtin_amdgcn_s_memrealtime() - t0 > 2000000ull) {
                    if (lane == 0) { unsigned expect = 0u; __hip_atomic_compare_exchange_strong(tmo + 1, &expect, code | (unsigned)(u.pm & 0xff), __ATOMIC_RELAXED, __ATOMIC_RELAXED, __HIP_MEMORY_SCOPE_AGENT);
                                     __hip_atomic_store(tmo, 1u, __ATOMIC_RELAXED, __HIP_MEMORY_SCOPE_AGENT); }
                    dead = true; break; }
                __builtin_amdgcn_s_sleep(2);
            }
            __builtin_amdgcn_fence(__ATOMIC_ACQUIRE, "agent");
            if (lane == 0) flag[0] = dead ? 1u : 0u;
        }
        asm volatile("s_waitcnt vmcnt(0) lgkmcnt(0)" ::: "memory"); __builtin_amdgcn_s_barrier(); asm volatile("" ::: "memory");
        const bool bad = flag[0] != 0u;
        if (lane < 32) {
            const unsigned long long* slot = (const unsigned long long*)xbuf + (size_t)(u.pm * BM + row) * 4; float mt[4], m2[4]; float ms = 0.f;
#pragma unroll
            for (int t = 0; t < 4; ++t) { if (t < ntn) { const unsigned long long w = __hip_atomic_load(slot + t, __ATOMIC_RELAXED, __HIP_MEMORY_SCOPE_AGENT); mt[t] = __uint_as_float((unsigned)w); m2[t] = __uint_as_float((unsigned)(w >> 32)); } else { mt[t] = 0.f; m2[t] = 0.f; } ms += mt[t]; }
            const float mean = ms / (float)ntn; float q = 0.f;
#pragma unroll
            for (int t = 0; t < 4; ++t) if (t < ntn) { const float dm = mt[t] - mean; q += m2[t] + 256.0f * dm * dm; }
            S[row] = (f32x2v){mean, 1.0f / sqrtf(q / (256.0f * (float)ntn) + eps)};
        }
        asm volatile("s_waitcnt lgkmcnt(0)" ::: "memory"); __builtin_amdgcn_s_barrier(); asm volatile("" ::: "memory");
        return bad;
    }
};
struct EpiLnRes {
    static constexpr bool PERM = false, AFTER_DRAIN = true;
    const float* base; float* out; int ldc; const float* bias; PanelStats st; unsigned poison;
    __device__ __forceinline__ void fused(f32x4 (&acc)[2][2][4][2], const Unit& u, int wr, int wc, int fr, int fq, PG8_LAS unsigned char* lds, int wid, int lane) const {
        typedef float f32x2v __attribute__((ext_vector_type(2)));
        const PG8_LAS f32x2v* S = (const PG8_LAS f32x2v*)(lds + 8192);
        const int col0 = u.pn * BM + wc * 32 + 4 * fq;
#pragma unroll
        for (int bj = 0; bj < 2; ++bj)
#pragma unroll
            for (int n = 0; n < 2; ++n) { const f32x4 bv = bias ? *(const f32x4*)(bias + col0 + bj * HALF + n * 16) : (f32x4){0.f, 0.f, 0.f, 0.f};
#pragma unroll
                for (int ai = 0; ai < 2; ++ai)
#pragma unroll
                    for (int m = 0; m < 4; ++m) acc[ai][bj][m][n] += bv; }
        f32x4 pre[4][2][2];
#pragma unroll
        for (int m = 0; m < 4; ++m) { const size_t off = (size_t)(u.pm * BM + wr * 64 + m * 16 + fr) * ldc + col0;
#pragma unroll
            for (int bj = 0; bj < 2; ++bj)
#pragma unroll
                for (int n = 0; n < 2; ++n) pre[m][bj][n] = *(const f32x4*)(base + off + bj * HALF + n * 16); }
        const bool bad = st.run(acc, u, wr, wc, fr, fq, lds, wid, lane) || poison != 0u;
        const float qnan = __builtin_nanf("");
#pragma unroll
        for (int ai = 0; ai < 2; ++ai)
#pragma unroll
            for (int m = 0; m < 4; ++m) { const int r = ai * HALF + wr * 64 + m * 16 + fr; const f32x2v sr = S[r]; const size_t off = (size_t)(u.pm * BM + r) * ldc + col0;
#pragma unroll
                for (int bj = 0; bj < 2; ++bj)
#pragma unroll
                    for (int n = 0; n < 2; ++n) { const f32x4 bs = ai == 0 ? pre[m][bj][n] : *(const f32x4*)(base + off + bj * HALF + n * 16); f32x4 o = bs + (acc[ai][bj][m][n] - sr.x) * sr.y;
                        if (bad) o = (f32x4){qnan, qnan, qnan, qnan}; *(f32x4*)(out + off + bj * HALF + n * 16) = o; }
                if (m & 1) asm volatile("" ::: "memory"); }
    }
};
struct EpiLnResLn {
    static constexpr bool PERM = false, AFTER_DRAIN = true;
    const float* base; float* out; bf16_t* xn; int ldc; const float* bias; PanelStats st1, st2; unsigned poison;
    __device__ __forceinline__ void fused(f32x4 (&acc)[2][2][4][2], const Unit& u, int wr, int wc, int fr, int fq, PG8_LAS unsigned char* lds, int wid, int lane) const {
        typedef float f32x2v __attribute__((ext_vector_type(2))); typedef unsigned u32x2v __attribute__((ext_vector_type(2)));
        const PG8_LAS f32x2v* S = (const PG8_LAS f32x2v*)(lds + 8192);
        const int col0 = u.pn * BM + wc * 32 + 4 * fq;
#pragma unroll
        for (int bj = 0; bj < 2; ++bj)
#pragma unroll
            for (int n = 0; n < 2; ++n) { const f32x4 bv = bias ? *(const f32x4*)(bias + col0 + bj * HALF + n * 16) : (f32x4){0.f, 0.f, 0.f, 0.f};
#pragma unroll
                for (int ai = 0; ai < 2; ++ai)
#pragma unroll
                    for (int m = 0; m < 4; ++m) acc[ai][bj][m][n] += bv; }
        bool bad = st1.run(acc, u, wr, wc, fr, fq, lds, wid, lane) || poison != 0u;
        const float qnan = __builtin_nanf("");
#pragma unroll
        for (int ai = 0; ai < 2; ++ai)
#pragma unroll
            for (int m = 0; m < 4; ++m) { const int r = ai * HALF + wr * 64 + m * 16 + fr; const f32x2v sr = S[r]; const size_t off = (size_t)(u.pm * BM + r) * ldc + col0;
#pragma unroll
                for (int bj = 0; bj < 2; ++bj)
#pragma unroll
                    for (int n = 0; n < 2; ++n) { const f32x4 bs = *(const f32x4*)(base + off + bj * HALF + n * 16); acc[ai][bj][m][n] = bs + (acc[ai][bj][m][n] - sr.x) * sr.y; }
                asm volatile("" : "+v"(acc[ai][0][m][0]), "+v"(acc[ai][0][m][1]), "+v"(acc[ai][1][m][0]), "+v"(acc[ai][1][m][1]));
                if (m & 1) asm volatile("" ::: "memory"); }
        const bool bad1 = bad;
        bad = st2.run(acc, u, wr, wc, fr, fq, lds, wid, lane) || bad;
#pragma unroll
        for (int ai = 0; ai < 2; ++ai)
#pragma unroll
            for (int m = 0; m < 4; ++m) { const int r = ai * HALF + wr * 64 + m * 16 + fr; const f32x2v sr = S[r]; const size_t off = (size_t)(u.pm * BM + r) * ldc + col0;
#pragma unroll
                for (int bj = 0; bj < 2; ++bj)
#pragma unroll
                    for (int n = 0; n < 2; ++n) { const f32x4 x1 = acc[ai][bj][m][n]; *(f32x4*)(out + off + bj * HALF + n * 16) = bad1 ? (f32x4){qnan, qnan, qnan, qnan} : x1;
                        const f32x4 o = (x1 - sr.x) * sr.y; u32x2v w; w.x = cvt_pk_bf16(o[0], o[1]); w.y = cvt_pk_bf16(o[2], o[3]);
                        if (bad) { w.x = 0x7fc07fc0u; w.y = 0x7fc07fc0u; } *(u32x2v*)(xn + off + bj * HALF + n * 16) = w; }
                asm volatile("" ::: "memory"); }
    }
};

template <class Epi, class Sched, bool ALIGN_EPI = false, bool SP2 = false>
__device__ __forceinline__ void gemm_phase(PG8_LAS unsigned char* lds, const Gemm g, const Sched& S, const Epi& E) {
    const int tid = threadIdx.x, wid = __builtin_amdgcn_readfirstlane(tid >> 6), lane = tid & 63, wr = wid >> 2, wc = wid & 3, fr = lane & 15, fq = lane >> 4;
    const int K = g.K, nt = K / BK;
    unsigned voffA[2], voffB[2];
#pragma unroll
    for (int i = 0; i < 2; ++i) { int R, C; stage_rc(tid * 16 + i * 8192, R, C); const int Rb = Epi::PERM ? ((R & ~31) + perm32(R & 31)) : R;
        voffA[i] = (unsigned)(R * K + C) * 2u; voffB[i] = (unsigned)(Rb * K + C) * 2u; }
    const size_t kstep = (size_t)(BK * 2);
    const size_t hstep = (size_t)HALF * K * 2;
    const size_t tstep = 2 * hstep;
    const unsigned ldsw = (unsigned)wid * 1024u;
    const int aoff = lds_byte(wr * 64 + fr, fq * 8), boff = lds_byte(wc * 32 + fr, fq * 8);
#define PG8_SA(b, h) (((b) * 2 + (h)) * HTB)
#define PG8_SB(b, h) ((4 + (b) * 2 + (h)) * HTB)
#define PG8_STAGE(bufoff, gbase, voff) do { _Pragma("unroll") for (int _i = 0; _i < 2; ++_i) \
        __builtin_amdgcn_global_load_lds((const unsigned*)((const char*)(gbase) + (voff)[_i]), (PG8_LAS unsigned*)(lds + (bufoff) + ldsw + _i * 8192), 16, 0, 0); } while (0)
#define PG8_LDA(dst, b, h) do { _Pragma("unroll") for (int m = 0; m < 4; ++m) _Pragma("unroll") for (int k = 0; k < 2; ++k) dst[m][k] = *(const PG8_LAS bf16x8*)(lds + PG8_SA(b, h) + aoff + m * 2048 + k * 1024); } while (0)
#define PG8_LDB(dst, b, h) do { _Pragma("unroll") for (int n = 0; n < 2; ++n) _Pragma("unroll") for (int k = 0; k < 2; ++k) dst[n][k] = *(const PG8_LAS bf16x8*)(lds + PG8_SB(b, h) + boff + n * 2048 + k * 1024); } while (0)
#define PG8_MMA(ai, bj, At, Bt) do { __builtin_amdgcn_s_setprio(1); _Pragma("unroll") for (int m = 0; m < 4; ++m) _Pragma("unroll") for (int n = 0; n < 2; ++n) _Pragma("unroll") for (int k = 0; k < 2; ++k) \
        acc[ai][bj][m][n] = __builtin_amdgcn_mfma_f32_16x16x32_bf16(Bt[n][k], At[m][k], acc[ai][bj][m][n], 0, 0, 0); __builtin_amdgcn_s_setprio(0); } while (0)
#define PG8_WAIT_V(n) asm volatile("s_waitcnt vmcnt(" #n ")" ::: "memory")
#define PG8_WAIT_L(n) asm volatile("s_waitcnt lgkmcnt(" #n ")" ::: "memory")
#define PG8_BAR __builtin_amdgcn_s_barrier()
#define PG8_SCHED __builtin_amdgcn_sched_barrier(0)
    Unit cur, nxt; int ui = 0;
    if (!S.next(0, cur)) return;
    f32x4 acc[2][2][4][2];
#pragma unroll
    for (int a = 0; a < 2; ++a)
#pragma unroll
        for (int b = 0; b < 2; ++b)
#pragma unroll
            for (int m = 0; m < 4; ++m)
#pragma unroll
                for (int n = 0; n < 2; ++n) acc[a][b][m][n] = (f32x4){0.f, 0.f, 0.f, 0.f};
    bf16x8 At[4][2], B0[2][2], B1[2][2];
    const char* cA = (const char*)g.A + (size_t)cur.pm * tstep; const char* cB = (const char*)g.Bt + (size_t)cur.pn * tstep;
    S.a_ready(cur);
    if constexpr (SP2) {
        PG8_STAGE(PG8_SB(0, 0), cB, voffB); PG8_STAGE(PG8_SB(0, 1), cB + hstep, voffB); PG8_STAGE(PG8_SA(0, 0), cA, voffA); PG8_STAGE(PG8_SA(0, 1), cA + hstep, voffA);
        if (wr == 1) PG8_BAR;
        PG8_WAIT_V(2); PG8_BAR;
        PG8_STAGE(PG8_SB(1, 0), cB + kstep, voffB); PG8_STAGE(PG8_SA(1, 0), cA + kstep, voffA); PG8_STAGE(PG8_SB(1, 1), cB + hstep + kstep, voffB);
        PG8_WAIT_V(6); PG8_BAR;
    } else {
        PG8_STAGE(PG8_SB(0, 0), cB, voffB); PG8_STAGE(PG8_SA(0, 0), cA, voffA); PG8_STAGE(PG8_SB(0, 1), cB + hstep, voffB); PG8_STAGE(PG8_SA(0, 1), cA + hstep, voffA);
        if (wr == 1) PG8_BAR;
        PG8_WAIT_V(4); PG8_BAR;
        PG8_STAGE(PG8_SB(1, 0), cB + kstep, voffB); PG8_STAGE(PG8_SA(1, 0), cA + kstep, voffA); PG8_STAGE(PG8_SB(1, 1), cB + hstep + kstep, voffB);
        PG8_WAIT_V(6); PG8_BAR;
    }
    for (;;) {
        const bool has_next = S.next(ui + 1, nxt);
        const char* nA = has_next ? (const char*)g.A + (size_t)nxt.pm * tstep : cA; const char* nB = has_next ? (const char*)g.Bt + (size_t)nxt.pn * tstep : cB;
        for (int t = 0; t < nt; t += 2) {
            const bool last = (t == nt - 2);
            const char* a1 = cA + (size_t)(t + 1) * kstep;
            const char* a2 = last ? nA : cA + (size_t)(t + 2) * kstep; const char* b2 = last ? nB : cB + (size_t)(t + 2) * kstep;
            const char* a3 = a2 + kstep; const char* b3 = b2 + kstep;
            if (last && has_next) S.a_ready(nxt);
            if constexpr (SP2) {
            PG8_LDB(B0, 0, 0); PG8_LDB(B1, 0, 1); PG8_SCHED; PG8_LDA(At, 0, 0); PG8_STAGE(PG8_SA(1, 1), a1 + hstep, voffA);
            PG8_WAIT_V(8); PG8_WAIT_L(0); PG8_BAR; PG8_MMA(0, 0, At, B0); PG8_MMA(0, 1, At, B1); PG8_BAR; PG8_SCHED;
            PG8_LDA(At, 0, 1); PG8_STAGE(PG8_SB(0, 0), b2, voffB); PG8_STAGE(PG8_SB(0, 1), b2 + hstep, voffB); PG8_STAGE(PG8_SA(0, 0), a2, voffA);
            PG8_WAIT_V(8); PG8_WAIT_L(0); PG8_BAR; PG8_MMA(1, 0, At, B0); PG8_MMA(1, 1, At, B1); PG8_BAR; PG8_SCHED;
            PG8_LDB(B0, 1, 0); PG8_LDB(B1, 1, 1); PG8_SCHED; PG8_LDA(At, 1, 0); PG8_STAGE(PG8_SA(0, 1), a2 + hstep, voffA);
            PG8_WAIT_V(8); PG8_WAIT_L(0); PG8_BAR; PG8_MMA(0, 0, At, B0); PG8_MMA(0, 1, At, B1); PG8_BAR; PG8_SCHED;
            PG8_LDA(At, 1, 1); PG8_STAGE(PG8_SB(1, 0), b3, voffB); PG8_STAGE(PG8_SB(1, 1), b3 + hstep, voffB); PG8_STAGE(PG8_SA(1, 0), a3, voffA);
            PG8_WAIT_V(8); PG8_WAIT_L(0); PG8_BAR; PG8_MMA(1, 0, At, B0); PG8_MMA(1, 1, At, B1); PG8_BAR; PG8_SCHED;
            } else {
            PG8_LDB(B0, 0, 0); PG8_SCHED; PG8_LDA(At, 0, 0); PG8_STAGE(PG8_SA(1, 1), a1 + hstep, voffA);
            PG8_WAIT_L(8); PG8_BAR; PG8_WAIT_L(0); PG8_MMA(0, 0, At, B0); PG8_BAR; PG8_SCHED;
            PG8_LDB(B1, 0, 1); PG8_STAGE(PG8_SB(0, 0), b2, voffB);
            PG8_BAR; PG8_WAIT_L(0); PG8_MMA(0, 1, At, B1); PG8_BAR;
            PG8_LDA(At, 0, 1); PG8_STAGE(PG8_SA(0, 0), a2, voffA);
            PG8_BAR; PG8_WAIT_L(0); PG8_MMA(1, 0, At, B0); PG8_BAR; PG8_SCHED;
            PG8_STAGE(PG8_SB(0, 1), b2 + hstep, voffB);
            PG8_WAIT_V(6); PG8_BAR; PG8_MMA(1, 1, At, B1); PG8_BAR;
            PG8_LDB(B0, 1, 0); PG8_SCHED; PG8_LDA(At, 1, 0); PG8_STAGE(PG8_SA(0, 1), a2 + hstep, voffA);
            PG8_WAIT_L(8); PG8_BAR; PG8_WAIT_L(0); PG8_MMA(0, 0, At, B0); PG8_BAR; PG8_SCHED;
            PG8_LDB(B1, 1, 1); PG8_STAGE(PG8_SB(1, 0), b3, voffB);
            PG8_BAR; PG8_WAIT_L(0); PG8_MMA(0, 1, At, B1); PG8_BAR;
            PG8_LDA(At, 1, 1); PG8_STAGE(PG8_SA(1, 0), a3, voffA);
            PG8_BAR; PG8_WAIT_L(0); PG8_MMA(1, 0, At, B0); PG8_BAR; PG8_SCHED;
            PG8_STAGE(PG8_SB(1, 1), b3 + hstep, voffB);
            PG8_WAIT_V(6); PG8_BAR; PG8_MMA(1, 1, At, B1); PG8_BAR;
            }
        }
        if constexpr (ALIGN_EPI) { if (wr == 0) PG8_BAR; }
        if constexpr (!Epi::AFTER_DRAIN) { E(acc, cur, wr, wc, fr, fq); S.done(cur); }
        if (!has_next) break;
#pragma unroll
        for (int a = 0; a < 2; ++a)
#pragma unroll
            for (int b = 0; b < 2; ++b)
#pragma unroll
                for (int m = 0; m < 4; ++m)
#pragma unroll
                    for (int n = 0; n < 2; ++n) acc[a][b][m][n] = (f32x4){0.f, 0.f, 0.f, 0.f};
        cur = nxt; cA = nA; cB = nB; ++ui;
        if constexpr (ALIGN_EPI) { if (wr == 1) PG8_BAR; }
    }
    PG8_WAIT_V(0);
    if constexpr (!ALIGN_EPI) { if (wr == 0) PG8_BAR; }
    PG8_BAR;
    if constexpr (Epi::AFTER_DRAIN) { E.fused(acc, cur, wr, wc, fr, fq, lds, wid, lane); S.done(cur); }
#undef PG8_SA
#undef PG8_SB
#undef PG8_STAGE
#undef PG8_LDA
#undef PG8_LDB
#undef PG8_MMA
#undef PG8_WAIT_V
#undef PG8_WAIT_L
#undef PG8_BAR
#undef PG8_SCHED
}
}


constexpr int BATCH = 8, SEQ = 4096, DM = 1024, MTOK = BATCH * SEQ;
constexpr int NH = 8, HD = 64;
constexpr int NPROJ = 4224, NPROJ_PAD = 4352;
constexpr int C_R = 0, C_K = 512, C_V = 1024, C_Q = 1536, C_KA = 2048, C_VA = 2560, C_G = 3072, C_WD = 4096, C_AD = 4160;
__host__ __device__ __forceinline__ int oldcol(int n) { return n < 1536 ? n : (n < 4096 ? n + 128 : n - 2560); }
constexpr float RMS_EPS = 1e-6f, GN_EPS = 64e-5f;

#define GAS __attribute__((address_space(1)))
#define LAS __attribute__((address_space(3)))
typedef unsigned short bf16;
typedef unsigned v4u __attribute__((ext_vector_type(4)));
typedef float f32x4 __attribute__((ext_vector_type(4)));
__device__ __forceinline__ unsigned f2bf(float f) { unsigned u = __builtin_bit_cast(unsigned, f); return (u + 0x7fffu + ((u >> 16) & 1u)) >> 16; }
__device__ __forceinline__ unsigned pk2(float lo, float hi) { return f2bf(lo) | (f2bf(hi) << 16); }
__device__ __forceinline__ float bf2f(bf16 v) { return __builtin_bit_cast(float, (unsigned)v << 16); }
__device__ __forceinline__ float wave_sum(float v) {
#pragma unroll
    for (int o = 1; o < 64; o <<= 1) v += __shfl_xor(v, o);
    return v;
}
__device__ __forceinline__ float wave_max(float v) {
#pragma unroll
    for (int o = 1; o < 64; o <<= 1) v = fmaxf(v, __shfl_xor(v, o));
    return v;
}
#define LDS_WAIT() asm volatile("s_waitcnt lgkmcnt(0)" ::: "memory")

constexpr size_t MiB = 1u << 20;
constexpr size_t WS_CTL = 0;
constexpr size_t WS_WIN = 2 * MiB;
constexpr size_t WS_WOUT = 11 * MiB;
constexpr size_t WS_KMEAN = 13 * MiB;
constexpr size_t WS_W2T = 13 * MiB + 512 * 1024, WS_A2T = WS_W2T + 65536;
constexpr size_t WS_XN = 16 * MiB;
constexpr size_t WS_MF = 16 * MiB;
constexpr size_t WS_RKV = 80 * MiB;
constexpr size_t WS_YBUF = 344 * MiB;
constexpr size_t WS_SEL = 14 * MiB;
constexpr size_t WS_PART = 80 * MiB;
constexpr size_t WS_ML = 176 * MiB;
constexpr size_t WS_WDAD = 176 * MiB;
constexpr size_t WS_QKVA = 184 * MiB;
constexpr size_t WS_GATES = 280 * MiB;
constexpr size_t WS_NA = 344 * MiB, WS_PF = 408 * MiB, WS_QA = 440 * MiB, WS_BV = 472 * MiB;
constexpr size_t WS_WDAD2 = 504 * MiB;
constexpr size_t WS_OBUF = 208 * MiB;
constexpr size_t WS_END = 512 * MiB;

__device__ __forceinline__ void p0_transpose_item(const float* W, int K, int N, bf16* WT, bool perm, LAS float* scr, int item, int lane) {
    const int nblk_new = perm ? (NPROJ / 32) : (N / 32);
    const int kb = item / nblk_new, nb = item % nblk_new, k0 = 64 * kb, n0new = 32 * nb, n0 = perm ? oldcol(n0new) : n0new;
#pragma unroll 8
    for (int i = 0; i < 32; ++i) { const int kk = 2 * i + (lane >> 5); scr[kk * 33 + (lane & 31)] = W[(size_t)(k0 + kk) * N + n0 + (lane & 31)]; }
    LDS_WAIT(); asm volatile("" ::: "memory");
    const int c = lane & 7;
#pragma unroll
    for (int j = 0; j < 4; ++j) { const int n = (lane >> 3) + 8 * j; const LAS float* s = scr + (8 * c) * 33 + n;
        v4u o; o.x = pk2(s[0 * 33], s[1 * 33]); o.y = pk2(s[2 * 33], s[3 * 33]); o.z = pk2(s[4 * 33], s[5 * 33]); o.w = pk2(s[6 * 33], s[7 * 33]);
        *(GAS v4u*)(WT + (size_t)(n0new + n) * K + k0 + 8 * c) = o; }
    LDS_WAIT(); asm volatile("" ::: "memory");
}
__device__ __forceinline__ void rms_row_to_bf16(const float* xrow, const float* g, bf16* orow, int lane) {
    const GAS f32x4* xr = (const GAS f32x4*)xrow + lane;
    const GAS f32x4* gr = (const GAS f32x4*)g + lane;
    f32x4 v[4]; float s = 0.f;
#pragma unroll
    for (int j = 0; j < 4; ++j) { v[j] = xr[64 * j]; s += (v[j].x * v[j].x + v[j].y * v[j].y) + (v[j].z * v[j].z + v[j].w * v[j].w); }
    const float rs = 1.f / sqrtf(wave_sum(s) * (1.f / DM) + RMS_EPS);
    GAS unsigned long long* o8 = (GAS unsigned long long*)orow + lane;
#pragma unroll
    for (int j = 0; j < 4; ++j) { const f32x4 gg = gr[64 * j];
        o8[64 * j] = (unsigned long long)pk2(v[j].x * rs * gg.x, v[j].y * rs * gg.y) | ((unsigned long long)pk2(v[j].z * rs * gg.z, v[j].w * rs * gg.w) << 32); }
}

#define XB_TMO      128
#define XB_XCNT(j)  (256  + 64 * (j))
#define XB_XSUB(j)  (1280 + 64 * (j))
#define XB_XGEN(j)  (2304 + 64 * (j))
#define XB_TOP      3328
#define XB_TOPGEN   3392
#define XCD_BAR_WORDS 3456
#define XB_SPIN_CAP (1u << 18)

__device__ __forceinline__ unsigned xb_ld(unsigned* p)              { return __hip_atomic_load(p, __ATOMIC_RELAXED, __HIP_MEMORY_SCOPE_AGENT); }
__device__ __forceinline__ unsigned xb_add(unsigned* p, unsigned v) { return __hip_atomic_fetch_add(p, v, __ATOMIC_RELAXED, __HIP_MEMORY_SCOPE_AGENT); }
__device__ __forceinline__ unsigned xb_xcc_id() { return (unsigned)__builtin_amdgcn_s_getreg((3 << 11) | 20) & 0xFu; }
#define XB_SPIN(cond, bar) do { unsigned _sp = 0; while (cond) { __builtin_amdgcn_s_sleep(1); \
    if ((++_sp & 255u) == 0u) { if (xb_ld(&(bar)[XB_TMO])) break; if (_sp > XB_SPIN_CAP) { atomicAdd(&(bar)[XB_TMO], 1u); break; } } } } while (0)

struct XcdBarrier {
    unsigned* bar; unsigned x;
    volatile LAS unsigned* st;
};

__device__ __forceinline__ XcdBarrier xcd_barrier_post(unsigned* bar, volatile LAS unsigned* st) {
    XcdBarrier b; b.bar = bar; b.x = xb_xcc_id(); b.st = st;
    if (threadIdx.x == 0) (void)xb_add(&bar[XB_XCNT(b.x)], 1u);
    return b;
}
__device__ __forceinline__ void xcd_barrier_complete(unsigned* bar, unsigned x, unsigned& nloc, unsigned& nx) {
    const unsigned G = gridDim.x * gridDim.y * gridDim.z;
    unsigned sum, cnt, mine, sp = 0u;
    for (;;) {
        sum = 0u; cnt = 0u; mine = 0u;
#pragma unroll
        for (unsigned j = 0; j < 16; ++j) { const unsigned c = xb_ld(&bar[XB_XCNT(j)]); sum += c; cnt += (c > 0u) ? 1u : 0u; mine = (j == x) ? c : mine; }
        if (sum == G) break;
        __builtin_amdgcn_s_sleep(1);
        if ((++sp & 255u) == 0u) { if (xb_ld(&bar[XB_TMO])) break; if (sp > XB_SPIN_CAP) { atomicAdd(&bar[XB_TMO], 1u); break; } }
    }
    nloc = mine > 0u ? mine : 1u; nx = cnt > 0u ? cnt : 1u;
}

__device__ __forceinline__ void xcd_barrier(const XcdBarrier& b) {
    asm volatile("s_waitcnt vmcnt(0)" ::: "memory");
    __syncthreads();
    if (threadIdx.x == 0) {
        unsigned* bar = b.bar;
        __builtin_amdgcn_s_waitcnt(0);
        unsigned nloc = b.st[0], nx = b.st[1];
        if (nloc == 0u) { xcd_barrier_complete(bar, b.x, nloc, nx); b.st[0] = nloc; b.st[1] = nx; }
        const unsigned old = xb_add(&bar[XB_XSUB(b.x)], 1u);
        const unsigned gen = old / nloc;
        if (old + 1u == (gen + 1u) * nloc) {
            __builtin_amdgcn_fence(__ATOMIC_RELEASE, "agent");
            asm volatile("s_waitcnt vmcnt(0)" ::: "memory");
            const unsigned og = xb_add(&bar[XB_TOP], 1u);
            const unsigned tg = og / nx;
            if (og + 1u == (tg + 1u) * nx) xb_add(&bar[XB_TOPGEN], 1u);
            else XB_SPIN(xb_ld(&bar[XB_TOPGEN]) == tg, bar);
            __builtin_amdgcn_fence(__ATOMIC_ACQUIRE, "agent");
            xb_add(&bar[XB_XGEN(b.x)], 1u);
            asm volatile("s_waitcnt vmcnt(0)" ::: "memory");
        } else {
            XB_SPIN(xb_ld(&bar[XB_XGEN(b.x)]) == gen, bar);
            __builtin_amdgcn_fence(__ATOMIC_ACQUIRE, "agent");
            asm volatile("s_waitcnt vmcnt(0)" ::: "memory");
        }
    }
    __syncthreads();
}


constexpr int NWAVES = 8;
constexpr int RING_OFF = 0, RING_BYTES = 131072;
constexpr int LDSCTL_OFF = 147456 - 512, MISC_OFF = LDSCTL_OFF + 320;
constexpr int LDS_BYTES = 147456;
constexpr size_t CTL_ZERO_BYTES = 1 * MiB;
constexpr int CW_BAR = 4096;
constexpr int CW_QUEUE = 64;
typedef GAS unsigned gu32;
#define RLX_AGENT __ATOMIC_RELAXED, __HIP_MEMORY_SCOPE_AGENT

struct Args { const float* in[15]; float* out; unsigned char* ws; };

__device__ __forceinline__ void phase_prologue(const Args& a, LAS unsigned char* lds, int tid, int lane, int wave) {
    LAS float* scr = (LAS float*)(lds + wave * 16384);
    const int gw = blockIdx.x * 8 + wave, NGW = gridDim.x * 8;
    bf16* WinT = (bf16*)(a.ws + WS_WIN); bf16* WoutT = (bf16*)(a.ws + WS_WOUT); bf16* XN = (bf16*)(a.ws + WS_XN);
    constexpr int I_IN = (DM / 64) * (NPROJ / 32), I_OUT = (DM / 64) * (DM / 32);
    for (int it = gw; it < I_IN + I_OUT; it += NGW) {
        if (it < I_IN) p0_transpose_item(a.in[2], DM, NPROJ, WinT, true, scr, it, lane);
        else p0_transpose_item(a.in[13], DM, DM, WoutT, false, scr, it - I_IN, lane);
    }
    { v4u z = {0u, 0u, 0u, 0u}; GAS v4u* p = (GAS v4u*)(WinT + (size_t)NPROJ * DM);
      for (int i = blockIdx.x * 512 + tid; i < 128 * 1024 * 2 / 16; i += gridDim.x * 512) p[i] = z; }
    { bf16* W2T = (bf16*)(a.ws + WS_W2T); bf16* A2T = (bf16*)(a.ws + WS_A2T);
      for (int i = blockIdx.x * 512 + tid; i < 512 * 64; i += gridDim.x * 512) { const int ch = i >> 6, j = i & 63; W2T[i] = (bf16)f2bf(a.in[5][j * 512 + ch]); A2T[i] = (bf16)f2bf(a.in[7][j * 512 + ch]); } }
    for (int m = gw; m < MTOK; m += NGW) rms_row_to_bf16(a.in[0] + (size_t)m * DM, a.in[1], XN + (size_t)m * DM, lane);
}

__device__ __forceinline__ void phase_final(const Args& a, int lane, int wave) {
    const int gw = blockIdx.x * 8 + wave, NGW = gridDim.x * 8;
    const float* O = (const float*)(a.ws + WS_OBUF);
    for (int m = gw; m < MTOK; m += NGW) {
        const f32x4* orow = (const f32x4*)(O + (size_t)m * DM) + lane; const f32x4* xr = (const f32x4*)(a.in[0] + (size_t)m * DM) + lane; const f32x4* gr = (const f32x4*)a.in[14] + lane;
        f32x4 v[4]; float s = 0.f;
#pragma unroll
        for (int j = 0; j < 4; ++j) { v[j] = orow[64 * j]; s += (v[j].x * v[j].x + v[j].y * v[j].y) + (v[j].z * v[j].z + v[j].w * v[j].w); }
        const float rs = 1.f / sqrtf(wave_sum(s) * (1.f / DM) + RMS_EPS);
        f32x4* outr = (f32x4*)(a.out + (size_t)m * DM) + lane;
#pragma unroll
        for (int j = 0; j < 4; ++j) outr[64 * j] = xr[64 * j] + v[j] * rs * gr[64 * j];
    }
}

__device__ __forceinline__ void phase_kmean(const Args& a, int tid) {
    const bf16* qkva = (const bf16*)(a.ws + WS_QKVA); float* km = (float*)(a.ws + WS_KMEAN);
    for (int u = blockIdx.x; u < BATCH * 16; u += gridDim.x) {
        const int b = u / 16, n = u % 16, c = tid;
        const bf16* p = qkva + ((size_t)b * SEQ + n * 256) * 1536 + 512 + c;
        float s = 0.f;
        for (int t = 0; t < 256; ++t) s += bf2f(p[(size_t)t * 1536]);
        km[(((size_t)b * NH + (c >> 6)) * 16 + n) * 64 + (c & 63)] = s * (1.f / 256.f);
    }
}

#define WAVE_LDS_SYNC() do { asm volatile("s_waitcnt lgkmcnt(0)" ::: "memory"); } while (0)

typedef float f32x16 __attribute__((ext_vector_type(16)));
typedef short bf16x8_t __attribute__((ext_vector_type(8)));
typedef unsigned u32x4_t __attribute__((ext_vector_type(4)));
typedef unsigned u32x2_t __attribute__((ext_vector_type(2)));
struct P8 { unsigned w[8]; };
#define MFMA32(a, b, c) __builtin_amdgcn_mfma_f32_32x32x16_bf16((a), (b), (c), 0, 0, 0)
__device__ __forceinline__ unsigned cvtpk(float lo, float hi) { typedef float f2 __attribute__((ext_vector_type(2))); typedef __bf16 b2 __attribute__((ext_vector_type(2))); f2 v = {lo, hi}; b2 b = __builtin_convertvector(v, b2); return __builtin_bit_cast(unsigned, b); }
__device__ __forceinline__ float bflo(unsigned u) { return __builtin_bit_cast(float, u << 16); }
__device__ __forceinline__ float bfhi(unsigned u) { return __builtin_bit_cast(float, u & 0xffff0000u); }
__device__ __forceinline__ P8 pack_tile(const f32x16& x) { P8 p;
#pragma unroll
    for (int q = 0; q < 8; ++q) p.w[q] = cvtpk(x[2 * q], x[2 * q + 1]);
    return p; }
__device__ __forceinline__ f32x16 unpack_tile(const P8& p) { f32x16 x;
#pragma unroll
    for (int q = 0; q < 8; ++q) { x[2 * q] = bflo(p.w[q]); x[2 * q + 1] = bfhi(p.w[q]); }
    return x; }
template <int S> __device__ __forceinline__ bf16x8_t frag(const P8& p) { u32x4_t v = {p.w[4 * S], p.w[4 * S + 1], p.w[4 * S + 2], p.w[4 * S + 3]}; return __builtin_bit_cast(bf16x8_t, v); }
__device__ __forceinline__ f32x16 zero16() { f32x16 z;
#pragma unroll
    for (int i = 0; i < 16; ++i) z[i] = 0.f;
    return z; }
__device__ __forceinline__ f32x16 mm1(const P8& a, const P8& b, f32x16 acc) { acc = MFMA32(frag<0>(a), frag<0>(b), acc); acc = MFMA32(frag<1>(a), frag<1>(b), acc); return acc; }

constexpr int RW_NUNITS = BATCH * NH * (SEQ / 32);
constexpr size_t RW_MF_BYTES = 8192, RW_NA_BYTES = 8192, RW_PF_BYTES = 4096, RW_QA_BYTES = 4096, RW_BV_BYTES = 4096;
constexpr int PT_MU = 0, PT_W0 = 1664, PT_A0 = 2176, PT_KK = 2688, PT_KA = 3200, PT_RK = 3712, PT_FLOATS = 4224;
constexpr int PREP_PT_BYTES = 17408, PREP_WAVE_BYTES = 16128;
constexpr int STG_PITCH = 144;
constexpr int STG_BYTES = 33 * STG_PITCH;
constexpr int AIMG_PITCH = 36;

struct RwkvBufs { const bf16* rkv; const bf16* wdad2; bf16* mf; bf16* na; bf16* pf; bf16* qa; bf16* bv; const bf16* w2t; const bf16* a2t; };

__device__ __forceinline__ void stage_tile(LAS unsigned char* img, const bf16* src_row0  , int ldsrc, bool first, int lane) {
#pragma unroll
    for (int it = 0; it < 5; ++it) {
        const int q = lane + 64 * it;
        if (q < 264) { const int row = q >> 3, ch = q & 7;
            v4u v = {0u, 0u, 0u, 0u};
            if (!(first && row == 0)) v = *(const GAS v4u*)(src_row0 + (ptrdiff_t)(row - 1) * ldsrc + ch * 8);
            *(LAS v4u*)(img + row * STG_PITCH + ch * 16) = v; }
    }
}

__device__ __forceinline__ void rwkv_prep_unit(const RwkvBufs& B, int unit, LAS unsigned char* wl, const LAS float* pt, int lane_in) {
    int lane = lane_in; asm volatile("" : "+v"(lane));
    const int r = lane & 31, lh = lane >> 5;
    const int c = unit & 127, hd = (unit >> 7) & 7, b = unit >> 10;
    const size_t m0 = (size_t)b * SEQ + c * 32;
    LAS unsigned char* S0 = wl; LAS unsigned char* S1 = wl + STG_BYTES; LAS unsigned char* S2 = wl + 2 * STG_BYTES;
    LAS float* cumc = (LAS float*)(wl + 3 * STG_BYTES);
    LAS float* aimg = (LAS float*)wl;
    stage_tile(S0, B.rkv + m0 * 1536 + hd * 64, 1536, c == 0, lane);
    stage_tile(S1, B.rkv + m0 * 1536 + 512 + hd * 64, 1536, c == 0, lane);
    stage_tile(S2, B.rkv + m0 * 1536 + 1024 + hd * 64, 1536, c == 0, lane);
    f32x16 lwv[2], dav[2];
    {
        bf16x8_t tw[4], ad[4];
#pragma unroll
        for (int s = 0; s < 4; ++s) { tw[s] = *(const GAS bf16x8_t*)(B.wdad2 + (m0 + r) * 128 + 16 * s + 8 * lh); ad[s] = *(const GAS bf16x8_t*)(B.wdad2 + (m0 + r) * 128 + 64 + 16 * s + 8 * lh); }
#pragma unroll
        for (int mt = 0; mt < 2; ++mt) { f32x16 a1 = zero16(), a2 = zero16();
#pragma unroll
            for (int s = 0; s < 4; ++s) { const bf16x8_t wa = *(const GAS bf16x8_t*)(B.w2t + (size_t)(hd * 64 + 32 * mt + r) * 64 + 16 * s + 8 * lh);
                const bf16x8_t aa = *(const GAS bf16x8_t*)(B.a2t + (size_t)(hd * 64 + 32 * mt + r) * 64 + 16 * s + 8 * lh);
                a1 = MFMA32(wa, tw[s], a1); a2 = MFMA32(aa, ad[s], a2); }
            lwv[mt] = a1; dav[mt] = a2; }
    }
#pragma unroll
    for (int it = 0; it < 2; ++it)
#pragma unroll
        for (int g = 0; g < 4; ++g) { const f32x4 w0v = *(const LAS f32x4*)(pt + PT_W0 + hd * 64 + 32 * it + 8 * g + 4 * lh);
#pragma unroll
            for (int e = 0; e < 4; ++e) { const int i = 4 * g + e; const float x = -(w0v[e] + lwv[it][i]);
                const float sp = fmaxf(x, 0.f) + __logf(1.f + __expf(-fabsf(x)));
                lwv[it][i] = -__expf(-sp - 0.5f); } }
#pragma unroll
    for (int d = 1; d < 32; d <<= 1)
#pragma unroll
        for (int it = 0; it < 2; ++it)
#pragma unroll
            for (int i = 0; i < 16; ++i) { const float y = __shfl_up(lwv[it][i], d, 32); if (r >= d) lwv[it][i] += y; }
    if (r == 31) {
#pragma unroll
        for (int it = 0; it < 2; ++it)
#pragma unroll
            for (int g = 0; g < 4; ++g) { f32x4 v = {lwv[it][4 * g], lwv[it][4 * g + 1], lwv[it][4 * g + 2], lwv[it][4 * g + 3]}; *(LAS f32x4*)(cumc + 32 * it + 8 * g + 4 * lh) = v; }
    }
#pragma unroll
    for (int it = 0; it < 2; ++it)
#pragma unroll
        for (int i = 0; i < 16; ++i) lwv[it][i] = __expf(lwv[it][i]);
    asm volatile("" ::: "memory");
    float n2 = 0.f;
#pragma unroll
    for (int it = 0; it < 2; ++it)
#pragma unroll
        for (int g = 0; g < 4; ++g) { const int cl0 = 32 * it + 8 * g + 4 * lh;
            const u32x2_t kc = *(const LAS u32x2_t*)(S1 + (r + 1) * STG_PITCH + cl0 * 2), kp = *(const LAS u32x2_t*)(S1 + r * STG_PITCH + cl0 * 2);
            const f32x4 muk = *(const LAS f32x4*)(pt + PT_MU + 512 + hd * 64 + cl0), kkv = *(const LAS f32x4*)(pt + PT_KK + hd * 64 + cl0);
            const float k0 = bflo(kc.x), k1 = bfhi(kc.x), k2 = bflo(kc.y), k3 = bfhi(kc.y), p0 = bflo(kp.x), p1 = bfhi(kp.x), p2 = bflo(kp.y), p3 = bfhi(kp.y);
            const float a0 = (k0 + (p0 - k0) * muk[0]) * kkv[0], a1 = (k1 + (p1 - k1) * muk[1]) * kkv[1], a2 = (k2 + (p2 - k2) * muk[2]) * kkv[2], a3 = (k3 + (p3 - k3) * muk[3]) * kkv[3];
            n2 += (a0 * a0 + a1 * a1) + (a2 * a2 + a3 * a3); asm volatile("" ::: "memory"); }
    n2 += __shfl_xor(n2, 32);
    const float kinv = 1.f / fmaxf(sqrtf(n2), 1e-12f);
    P8 ACT[2], RCT[2], BCT[2], KCT[2];
    float bon = 0.f;
#pragma unroll
    for (int it = 0; it < 2; ++it)
#pragma unroll
        for (int g = 0; g < 4; ++g) { const int cl0 = 32 * it + 8 * g + 4 * lh, ch0 = hd * 64 + cl0;
            const u32x2_t rc = *(const LAS u32x2_t*)(S0 + (r + 1) * STG_PITCH + cl0 * 2), rp = *(const LAS u32x2_t*)(S0 + r * STG_PITCH + cl0 * 2);
            const u32x2_t kc = *(const LAS u32x2_t*)(S1 + (r + 1) * STG_PITCH + cl0 * 2), kp = *(const LAS u32x2_t*)(S1 + r * STG_PITCH + cl0 * 2);
            const f32x4 mur = *(const LAS f32x4*)(pt + PT_MU + ch0), muk = *(const LAS f32x4*)(pt + PT_MU + 512 + ch0);
            const f32x4 a0v = *(const LAS f32x4*)(pt + PT_A0 + ch0), kkv = *(const LAS f32x4*)(pt + PT_KK + ch0), kav = *(const LAS f32x4*)(pt + PT_KA + ch0), rkv = *(const LAS f32x4*)(pt + PT_RK + ch0);
            const float rr[4] = {bflo(rc.x), bfhi(rc.x), bflo(rc.y), bfhi(rc.y)}, rq[4] = {bflo(rp.x), bfhi(rp.x), bflo(rp.y), bfhi(rp.y)};
            const float kr[4] = {bflo(kc.x), bfhi(kc.x), bflo(kc.y), bfhi(kc.y)}, kq[4] = {bflo(kp.x), bfhi(kp.x), bflo(kp.y), bfhi(kp.y)};
            float oA[4], oR[4], oB[4], oK[4];
#pragma unroll
            for (int e = 0; e < 4; ++e) { const int i = 4 * g + e;
                const float rs = rr[e] + (rq[e] - rr[e]) * mur[e], ks = kr[e] + (kq[e] - kr[e]) * muk[e];
                const float aa = __builtin_amdgcn_rcpf(1.f + __expf(-(a0v[e] + dav[it][i])));
                const float kk = ks * kkv[e] * kinv;
                const float kpr = ks * (1.f + (aa - 1.f) * kav[e]);
                bon += rs * kpr * rkv[e];
                const float e2 = lwv[it][i]; float e1 = __shfl_up(e2, 1, 32); e1 = (r == 0) ? 1.f : e1;
                const float e3 = __builtin_amdgcn_rcpf(e2);
                oA[e] = -kk * e1; oR[e] = rs * e2; oB[e] = kk * aa * e3; oK[e] = kpr * e3; }
            ACT[it].w[2 * g] = cvtpk(oA[0], oA[1]); ACT[it].w[2 * g + 1] = cvtpk(oA[2], oA[3]);
            RCT[it].w[2 * g] = cvtpk(oR[0], oR[1]); RCT[it].w[2 * g + 1] = cvtpk(oR[2], oR[3]);
            BCT[it].w[2 * g] = cvtpk(oB[0], oB[1]); BCT[it].w[2 * g + 1] = cvtpk(oB[2], oB[3]);
            KCT[it].w[2 * g] = cvtpk(oK[0], oK[1]); KCT[it].w[2 * g + 1] = cvtpk(oK[2], oK[3]);
            asm volatile("" ::: "memory"); }
    bon += __shfl_xor(bon, 32);
    const float gam0 = __expf(cumc[r]), gam1 = __expf(cumc[32 + r]);
    LDS_WAIT(); asm volatile("" ::: "memory");
    { f32x16 acc = zero16(); acc = mm1(ACT[0], BCT[0], acc); acc = mm1(ACT[1], BCT[1], acc);
#pragma unroll
      for (int g = 0; g < 4; ++g) { f32x4 v;
#pragma unroll
          for (int e = 0; e < 4; ++e) v[e] = (8 * g + 4 * lh + e > r) ? acc[4 * g + e] : 0.f;
          *(LAS f32x4*)(aimg + r * AIMG_PITCH + 8 * g + 4 * lh) = v; } }
    float Tr[32];
#pragma unroll
    for (int j = 0; j < 32; ++j) Tr[j] = (j == r) ? 1.f : 0.f;
    LDS_WAIT(); asm volatile("" ::: "memory");
#pragma unroll
    for (int j = 30; j >= 0; --j) { float acc = 0.f;
#pragma unroll
        for (int q = (j + 1) >> 2; q < 8; ++q) { const f32x4 av = *(const LAS f32x4*)(aimg + j * AIMG_PITCH + 4 * q);
            acc += Tr[4 * q] * av[0] + Tr[4 * q + 1] * av[1] + Tr[4 * q + 2] * av[2] + Tr[4 * q + 3] * av[3]; }
        Tr[j] = (r > j) ? acc : Tr[j]; }
    P8 XT;
#pragma unroll
    for (int q = 0; q < 8; ++q) { const int i0 = 2 * q, i1 = 2 * q + 1;
        const float v0 = lh ? Tr[(i0 & 3) + 8 * (i0 >> 2) + 4] : Tr[(i0 & 3) + 8 * (i0 >> 2)], v1 = lh ? Tr[(i1 & 3) + 8 * (i1 >> 2) + 4] : Tr[(i1 & 3) + 8 * (i1 >> 2)];
        XT.w[q] = cvtpk(v0, v1); }
    P8 Aak, Arb, Ark;
    { f32x16 acc = zero16(); acc = mm1(KCT[0], ACT[0], acc); acc = mm1(KCT[1], ACT[1], acc);
#pragma unroll
      for (int i = 0; i < 16; ++i) acc[i] = ((i & 3) + 8 * (i >> 2) + 4 * lh < r) ? acc[i] : 0.f;
      Aak = pack_tile(acc); }
    { f32x16 acc = zero16(); acc = mm1(BCT[0], RCT[0], acc); acc = mm1(BCT[1], RCT[1], acc);
#pragma unroll
      for (int i = 0; i < 16; ++i) acc[i] = ((i & 3) + 8 * (i >> 2) + 4 * lh <= r) ? acc[i] : 0.f;
      Arb = pack_tile(acc); }
    { f32x16 acc = zero16(); acc = mm1(KCT[0], RCT[0], acc); acc = mm1(KCT[1], RCT[1], acc);
#pragma unroll
      for (int i = 0; i < 16; ++i) acc[i] = ((i & 3) + 8 * (i >> 2) + 4 * lh <= r) ? acc[i] : 0.f;
      Ark = pack_tile(acc); }
    P8 If;
#pragma unroll
    for (int q = 0; q < 8; ++q) { const int i0 = 2 * q, i1 = 2 * q + 1;
        const unsigned lo = ((i0 & 3) + 8 * (i0 >> 2) + 4 * lh == r) ? 0x3f80u : 0u, hi = ((i1 & 3) + 8 * (i1 >> 2) + 4 * lh == r) ? 0x3f800000u : 0u; If.w[q] = lo | hi; }
    P8 VC[2], AC[2], BhC[2], KhC[2];
#pragma unroll
    for (int ct = 0; ct < 2; ++ct) {
        AC[ct] = pack_tile(mm1(ACT[ct], If, zero16()));
        P8 VCT; f32x16 bvv;
#pragma unroll
        for (int g = 0; g < 4; ++g) { const int cl0 = 32 * ct + 8 * g + 4 * lh;
            const u32x2_t vc = *(const LAS u32x2_t*)(S2 + (r + 1) * STG_PITCH + cl0 * 2), vp = *(const LAS u32x2_t*)(S2 + r * STG_PITCH + cl0 * 2);
            const f32x4 muv = *(const LAS f32x4*)(pt + PT_MU + 1024 + hd * 64 + cl0);
            const float v0 = bflo(vc.x), v1 = bfhi(vc.x), v2 = bflo(vc.y), v3 = bfhi(vc.y), q0 = bflo(vp.x), q1 = bfhi(vp.x), q2 = bflo(vp.y), q3 = bfhi(vp.y);
            const float s0 = v0 + (q0 - v0) * muv[0], s1 = v1 + (q1 - v1) * muv[1], s2 = v2 + (q2 - v2) * muv[2], s3 = v3 + (q3 - v3) * muv[3];
            VCT.w[2 * g] = cvtpk(s0, s1); VCT.w[2 * g + 1] = cvtpk(s2, s3);
            bvv[4 * g] = s0 * bon; bvv[4 * g + 1] = s1 * bon; bvv[4 * g + 2] = s2 * bon; bvv[4 * g + 3] = s3 * bon; }
        { const P8 p = pack_tile(bvv); GAS u32x4_t* dst = (GAS u32x4_t*)(B.bv + (size_t)unit * (RW_BV_BYTES / 2) + (size_t)(ct * 64 + lane) * 16);
          dst[0] = (u32x4_t){p.w[0], p.w[1], p.w[2], p.w[3]}; dst[1] = (u32x4_t){p.w[4], p.w[5], p.w[6], p.w[7]}; }
        VC[ct] = pack_tile(mm1(VCT, If, zero16()));
        f32x16 bh = unpack_tile(BCT[ct]), kh = unpack_tile(KCT[ct]);
#pragma unroll
        for (int g = 0; g < 4; ++g) { const f32x4 cc = *(const LAS f32x4*)(cumc + 32 * ct + 8 * g + 4 * lh);
#pragma unroll
            for (int e = 0; e < 4; ++e) { const float gm = __expf(cc[e]); bh[4 * g + e] *= gm; kh[4 * g + e] *= gm; } }
        BhC[ct] = pack_tile(mm1(pack_tile(bh), If, zero16())); KhC[ct] = pack_tile(mm1(pack_tile(kh), If, zero16()));
        asm volatile("" ::: "memory"); }
    P8 UC[2], WC[2];
#pragma unroll
    for (int ct = 0; ct < 2; ++ct) { const P8 X1 = pack_tile(mm1(Aak, VC[ct], zero16())); UC[ct] = pack_tile(mm1(XT, X1, zero16())); WC[ct] = pack_tile(mm1(XT, AC[ct], zero16())); }
    { bf16* mfp = B.mf + (size_t)unit * (RW_MF_BYTES / 2);
#pragma unroll
      for (int cpt = 0; cpt < 2; ++cpt)
#pragma unroll
          for (int ct = 0; ct < 2; ++ct) { f32x16 acc = mm1(WC[cpt], BhC[ct], zero16());
              if (cpt == ct) { const float gm = ct ? gam1 : gam0;
#pragma unroll
                  for (int i = 0; i < 16; ++i) acc[i] += ((i & 3) + 8 * (i >> 2) + 4 * lh == r) ? gm : 0.f; }
              const P8 p = pack_tile(acc);
              *(GAS u32x4_t*)(mfp + (size_t)(((ct * 2 + cpt) * 2 + 0) * 64 + lane) * 8) = (u32x4_t){p.w[0], p.w[1], p.w[2], p.w[3]};
              *(GAS u32x4_t*)(mfp + (size_t)(((ct * 2 + cpt) * 2 + 1) * 64 + lane) * 8) = (u32x4_t){p.w[4], p.w[5], p.w[6], p.w[7]}; } }
    { bf16* nap = B.na + (size_t)unit * (RW_NA_BYTES / 2);
#pragma unroll
      for (int ct = 0; ct < 2; ++ct)
#pragma unroll
          for (int vt = 0; vt < 2; ++vt) { f32x16 acc = mm1(BhC[ct], UC[vt], zero16()); acc = mm1(KhC[ct], VC[vt], acc);
              const P8 p = pack_tile(acc); GAS u32x4_t* dst = (GAS u32x4_t*)(nap + (size_t)((ct * 2 + vt) * 64 + lane) * 16);
              dst[0] = (u32x4_t){p.w[0], p.w[1], p.w[2], p.w[3]}; dst[1] = (u32x4_t){p.w[4], p.w[5], p.w[6], p.w[7]}; } }
    { bf16* pfp = B.pf + (size_t)unit * (RW_PF_BYTES / 2);
#pragma unroll
      for (int ct = 0; ct < 2; ++ct) { f32x16 acc = mm1(WC[ct], Arb, unpack_tile(RCT[ct]));
          const P8 p = pack_tile(acc);
          *(GAS u32x4_t*)(pfp + (size_t)((ct * 2 + 0) * 64 + lane) * 8) = (u32x4_t){p.w[0], p.w[1], p.w[2], p.w[3]};
          *(GAS u32x4_t*)(pfp + (size_t)((ct * 2 + 1) * 64 + lane) * 8) = (u32x4_t){p.w[4], p.w[5], p.w[6], p.w[7]}; } }
    { bf16* qap = B.qa + (size_t)unit * (RW_QA_BYTES / 2);
#pragma unroll
      for (int vt = 0; vt < 2; ++vt) { f32x16 acc = mm1(UC[vt], Arb, zero16()); acc = mm1(VC[vt], Ark, acc);
          const P8 p = pack_tile(acc); GAS u32x4_t* dst = (GAS u32x4_t*)(qap + (size_t)(vt * 64 + lane) * 16);
          dst[0] = (u32x4_t){p.w[0], p.w[1], p.w[2], p.w[3]}; dst[1] = (u32x4_t){p.w[4], p.w[5], p.w[6], p.w[7]}; } }
    LDS_WAIT(); asm volatile("" ::: "memory");
}

struct SeqIn { u32x4_t mf[8]; u32x4_t na[2][2]; u32x4_t pf[4]; u32x4_t qa[2]; };
__device__ __forceinline__ void seq_load(SeqIn& s, const RwkvBufs& B, int unit, int vt, int lane) {
    const bf16* mfp = B.mf + (size_t)unit * (RW_MF_BYTES / 2);
#pragma unroll
    for (int f = 0; f < 8; ++f) s.mf[f] = *(const GAS u32x4_t*)(mfp + (size_t)(f * 64 + lane) * 8);
    const bf16* nap = B.na + (size_t)unit * (RW_NA_BYTES / 2);
#pragma unroll
    for (int ct = 0; ct < 2; ++ct) { const GAS u32x4_t* p = (const GAS u32x4_t*)(nap + (size_t)((ct * 2 + vt) * 64 + lane) * 16); s.na[ct][0] = p[0]; s.na[ct][1] = p[1]; }
    const bf16* pfp = B.pf + (size_t)unit * (RW_PF_BYTES / 2);
#pragma unroll
    for (int f = 0; f < 4; ++f) s.pf[f] = *(const GAS u32x4_t*)(pfp + (size_t)(f * 64 + lane) * 8);
    const GAS u32x4_t* q = (const GAS u32x4_t*)(B.qa + (size_t)unit * (RW_QA_BYTES / 2) + (size_t)(vt * 64 + lane) * 16); s.qa[0] = q[0]; s.qa[1] = q[1];
}
__device__ __forceinline__ f32x16 unpack2(const u32x4_t& a, const u32x4_t& b) { P8 p; p.w[0] = a[0]; p.w[1] = a[1]; p.w[2] = a[2]; p.w[3] = a[3]; p.w[4] = b[0]; p.w[5] = b[1]; p.w[6] = b[2]; p.w[7] = b[3]; return unpack_tile(p); }
__device__ __forceinline__ void rwkv_seq_wave(const RwkvBufs& B, int bh, int vt, int lane) {
    f32x16 H[2] = {zero16(), zero16()};
    SeqIn cur, nxt;
    seq_load(cur, B, bh * 128, vt, lane);
    for (int c = 0; c < 128; ++c) {
        const int unit = bh * 128 + c;
        if (c + 1 < 128) seq_load(nxt, B, unit + 1, vt, lane);
        const P8 HP0 = pack_tile(H[0]), HP1 = pack_tile(H[1]);
        f32x16 yt = unpack2(cur.qa[0], cur.qa[1]);
        yt = MFMA32(frag<0>(HP0), __builtin_bit_cast(bf16x8_t, cur.pf[0]), yt); yt = MFMA32(frag<1>(HP0), __builtin_bit_cast(bf16x8_t, cur.pf[1]), yt);
        yt = MFMA32(frag<0>(HP1), __builtin_bit_cast(bf16x8_t, cur.pf[2]), yt); yt = MFMA32(frag<1>(HP1), __builtin_bit_cast(bf16x8_t, cur.pf[3]), yt);
        f32x16 hn[2];
#pragma unroll
        for (int ct = 0; ct < 2; ++ct) { f32x16 acc = unpack2(cur.na[ct][0], cur.na[ct][1]);
            acc = MFMA32(__builtin_bit_cast(bf16x8_t, cur.mf[(ct * 2 + 0) * 2 + 0]), frag<0>(HP0), acc); acc = MFMA32(__builtin_bit_cast(bf16x8_t, cur.mf[(ct * 2 + 0) * 2 + 1]), frag<1>(HP0), acc);
            acc = MFMA32(__builtin_bit_cast(bf16x8_t, cur.mf[(ct * 2 + 1) * 2 + 0]), frag<0>(HP1), acc); acc = MFMA32(__builtin_bit_cast(bf16x8_t, cur.mf[(ct * 2 + 1) * 2 + 1]), frag<1>(HP1), acc);
            hn[ct] = acc; }
        H[0] = hn[0]; H[1] = hn[1];
        const P8 yp = pack_tile(yt);
        GAS u32x4_t* q = (GAS u32x4_t*)(B.qa + (size_t)unit * (RW_QA_BYTES / 2) + (size_t)(vt * 64 + lane) * 16);
        q[0] = (u32x4_t){yp.w[0], yp.w[1], yp.w[2], yp.w[3]}; q[1] = (u32x4_t){yp.w[4], yp.w[5], yp.w[6], yp.w[7]};
        cur = nxt;
    }
}

__device__ __forceinline__ void rwkv_post_unit(const RwkvBufs& B, const bf16* gates, const float* lnw, const float* lnb, bf16* ybuf, int unit, int lane) {
    const int r = lane & 31, lh = lane >> 5;
    const int c = unit & 127, hd = (unit >> 7) & 7, b = unit >> 10;
    const size_t m = (size_t)b * SEQ + c * 32 + r;
    f32x16 y[2], bvv[2];
#pragma unroll
    for (int vt = 0; vt < 2; ++vt) { const GAS u32x4_t* q = (const GAS u32x4_t*)(B.qa + (size_t)unit * (RW_QA_BYTES / 2) + (size_t)(vt * 64 + lane) * 16); const u32x4_t q0 = q[0], q1 = q[1]; y[vt] = unpack2(q0, q1);
        const GAS u32x4_t* p = (const GAS u32x4_t*)(B.bv + (size_t)unit * (RW_BV_BYTES / 2) + (size_t)(vt * 64 + lane) * 16); const u32x4_t p0 = p[0], p1 = p[1]; bvv[vt] = unpack2(p0, p1); }
    float s = 0.f;
#pragma unroll
    for (int vt = 0; vt < 2; ++vt)
#pragma unroll
        for (int i = 0; i < 16; ++i) s += y[vt][i];
    s += __shfl_xor(s, 32); const float mean = s * (1.f / 64.f);
    float q2 = 0.f;
#pragma unroll
    for (int vt = 0; vt < 2; ++vt)
#pragma unroll
        for (int i = 0; i < 16; ++i) { const float d = y[vt][i] - mean; q2 += d * d; }
    q2 += __shfl_xor(q2, 32); const float rstd = 1.f / sqrtf(q2 * (1.f / 64.f) + GN_EPS);
#pragma unroll
    for (int vt = 0; vt < 2; ++vt)
#pragma unroll
        for (int g = 0; g < 4; ++g) { const int ch0 = hd * 64 + 32 * vt + 8 * g + 4 * lh;
            const f32x4 lw = *(const GAS f32x4*)(lnw + ch0), lb = *(const GAS f32x4*)(lnb + ch0);
            const u32x2_t gt = *(const GAS u32x2_t*)(gates + m * 1024 + ch0);
            const float gg[4] = {bflo(gt.x), bfhi(gt.x), bflo(gt.y), bfhi(gt.y)}; float o[4];
#pragma unroll
            for (int e = 0; e < 4; ++e) { const int i = 4 * g + e; const float v = (y[vt][i] - mean) * rstd * lw[e] + lb[e] + bvv[vt][i]; o[e] = v * gg[e] * __builtin_amdgcn_rcpf(1.f + __expf(-gg[e])); }
            u32x2_t w; w.x = cvtpk(o[0], o[1]); w.y = cvtpk(o[2], o[3]);
            *(GAS u32x2_t*)(ybuf + m * DM + ch0) = w; }
}

constexpr int SEQ_D = 8, SEQ_SLOT = 24576;
#define SEQ_BAR() do { asm volatile("s_waitcnt lgkmcnt(0)" ::: "memory"); __builtin_amdgcn_s_barrier(); asm volatile("" ::: "memory"); } while (0)
__device__ __forceinline__ void rwkv_seq_block(const RwkvBufs& B, int bh, LAS unsigned char* lds, int wave, int lane) {
    const bool loader = wave >= 2;
    const char* src[4]; unsigned stride[4]; unsigned loff[4]; u32x4_t buf[SEQ_D][4];
    if (loader) {
#pragma unroll
        for (int j = 0; j < 4; ++j) { const unsigned p = (unsigned)((wave - 2) * 64 + lane + 384 * j), off = 16u * p; loff[j] = off;
            if (off < 8192u) { src[j] = (const char*)B.mf + off; stride[j] = 8192u; }
            else if (off < 16384u) { src[j] = (const char*)B.na + (off - 8192u); stride[j] = 8192u; }
            else if (off < 20480u) { src[j] = (const char*)B.pf + (off - 16384u); stride[j] = 4096u; }
            else { src[j] = (const char*)B.qa + (off - 20480u); stride[j] = 4096u; } }
#pragma unroll
        for (int d = 0; d < SEQ_D; ++d)
#pragma unroll
            for (int j = 0; j < 4; ++j) buf[d][j] = *(const GAS u32x4_t*)(src[j] + (size_t)(bh * 128 + d) * stride[j]);
#pragma unroll
        for (int j = 0; j < 4; ++j) *(LAS u32x4_t*)(lds + loff[j]) = buf[0][j];
#pragma unroll
        for (int j = 0; j < 4; ++j) buf[0][j] = *(const GAS u32x4_t*)(src[j] + (size_t)(bh * 128 + SEQ_D) * stride[j]);
    }
    __syncthreads();
    if (loader) {
#pragma unroll
        for (int k0 = 0; k0 < 128; k0 += SEQ_D) {
#pragma unroll
            for (int dd = 0; dd < SEQ_D; ++dd) { const int k = k0 + dd;
                if (k + 1 < 128) {
#pragma unroll
                    for (int j = 0; j < 4; ++j) *(LAS u32x4_t*)(lds + ((k + 1) & 1) * SEQ_SLOT + loff[j]) = buf[(dd + 1) % SEQ_D][j]; }
                if (k + 1 + SEQ_D < 128) {
#pragma unroll
                    for (int j = 0; j < 4; ++j) buf[(dd + 1) % SEQ_D][j] = *(const GAS u32x4_t*)(src[j] + (size_t)(bh * 128 + k + 1 + SEQ_D) * stride[j]); }
                SEQ_BAR();
            }
        }
    } else {
        f32x16 H[2] = {zero16(), zero16()};
        const int vt = wave;
        for (int k = 0; k < 128; ++k) {
            LAS unsigned char* sl = lds + (k & 1) * SEQ_SLOT;
            const P8 HP0 = pack_tile(H[0]), HP1 = pack_tile(H[1]);
            const u32x4_t q0 = *(const LAS u32x4_t*)(sl + 20480 + (vt * 64 + lane) * 32), q1 = *(const LAS u32x4_t*)(sl + 20480 + (vt * 64 + lane) * 32 + 16);
            f32x16 yt = unpack2(q0, q1);
            yt = MFMA32(frag<0>(HP0), *(const LAS bf16x8_t*)(sl + 16384 + (0 * 64 + lane) * 16), yt); yt = MFMA32(frag<1>(HP0), *(const LAS bf16x8_t*)(sl + 16384 + (1 * 64 + lane) * 16), yt);
            yt = MFMA32(frag<0>(HP1), *(const LAS bf16x8_t*)(sl + 16384 + (2 * 64 + lane) * 16), yt); yt = MFMA32(frag<1>(HP1), *(const LAS bf16x8_t*)(sl + 16384 + (3 * 64 + lane) * 16), yt);
            f32x16 hn[2];
#pragma unroll
            for (int ct = 0; ct < 2; ++ct) { const u32x4_t n0 = *(const LAS u32x4_t*)(sl + 8192 + ((ct * 2 + vt) * 64 + lane) * 32), n1 = *(const LAS u32x4_t*)(sl + 8192 + ((ct * 2 + vt) * 64 + lane) * 32 + 16);
                f32x16 acc = unpack2(n0, n1);
                acc = MFMA32(*(const LAS bf16x8_t*)(sl + (((ct * 2 + 0) * 2 + 0) * 64 + lane) * 16), frag<0>(HP0), acc); acc = MFMA32(*(const LAS bf16x8_t*)(sl + (((ct * 2 + 0) * 2 + 1) * 64 + lane) * 16), frag<1>(HP0), acc);
                acc = MFMA32(*(const LAS bf16x8_t*)(sl + (((ct * 2 + 1) * 2 + 0) * 64 + lane) * 16), frag<0>(HP1), acc); acc = MFMA32(*(const LAS bf16x8_t*)(sl + (((ct * 2 + 1) * 2 + 1) * 64 + lane) * 16), frag<1>(HP1), acc);
                hn[ct] = acc; }
            H[0] = hn[0]; H[1] = hn[1];
            const P8 yp = pack_tile(yt);
            GAS u32x4_t* q = (GAS u32x4_t*)(B.qa + (size_t)(bh * 128 + k) * (RW_QA_BYTES / 2) + (size_t)(vt * 64 + lane) * 16);
            q[0] = (u32x4_t){yp.w[0], yp.w[1], yp.w[2], yp.w[3]}; q[1] = (u32x4_t){yp.w[4], yp.w[5], yp.w[6], yp.w[7]};
            SEQ_BAR();
        }
    }
}

constexpr float LOG2E = 1.4426950408889634f;
constexpr int MB_KF = 0, MB_VF = 32768, MB_LIST = 65536, MB_CNT = 65536 + 8192;
struct MobaBufs { const bf16* qkva; const float* kmean; unsigned* sel; bf16* part; float* ml; const bf16* gates; bf16* ybuf; };

__device__ __forceinline__ void moba_gate_unit(const MobaBufs& M, int unit, LAS unsigned char* lds, int tid) {
    const int bh = unit >> 3, ck = unit & 7, b = bh >> 3, h = bh & 7;
    LAS float* km = (LAS float*)lds;
    __syncthreads();
    for (int i = tid; i < 1024; i += 512) km[i] = M.kmean[(size_t)bh * 1024 + i];
    __syncthreads();
    const int t = ck * 512 + tid, qb = t >> 8;
    const bf16* qp = M.qkva + ((size_t)b * SEQ + t) * 1536 + h * 64;
    float q[64];
#pragma unroll
    for (int c8 = 0; c8 < 8; ++c8) { const v4u v = *(const GAS v4u*)(qp + c8 * 8);
        q[c8 * 8 + 0] = bflo(v.x); q[c8 * 8 + 1] = bfhi(v.x); q[c8 * 8 + 2] = bflo(v.y); q[c8 * 8 + 3] = bfhi(v.y);
        q[c8 * 8 + 4] = bflo(v.z); q[c8 * 8 + 5] = bfhi(v.z); q[c8 * 8 + 6] = bflo(v.w); q[c8 * 8 + 7] = bfhi(v.w); }
    float g0 = -3e38f, g1 = -3e38f, g2 = -3e38f; unsigned i0 = 0xffu, i1 = 0xffu, i2 = 0xffu;
    for (int n = 0; n < qb; ++n) { float g = 0.f;
#pragma unroll
        for (int d4 = 0; d4 < 16; ++d4) { const f32x4 kv = *(const LAS f32x4*)(km + n * 64 + d4 * 4);
            g += q[d4 * 4] * kv[0] + q[d4 * 4 + 1] * kv[1] + q[d4 * 4 + 2] * kv[2] + q[d4 * 4 + 3] * kv[3]; }
        if (g > g0) { g2 = g1; i2 = i1; g1 = g0; i1 = i0; g0 = g; i0 = (unsigned)n; }
        else if (g > g1) { g2 = g1; i2 = i1; g1 = g; i1 = (unsigned)n; }
        else if (g > g2) { g2 = g; i2 = (unsigned)n; } }
    M.sel[(size_t)bh * SEQ + t] = i0 | (i1 << 8) | (i2 << 16);
}

__device__ __forceinline__ void moba_stage_kv(const MobaBufs& M, size_t kvrow0, int h, LAS unsigned char* lds, int wave, int lane) {
    const int r = lane & 31, lh = lane >> 5;
    const bf16* kp = M.qkva + (kvrow0 + 32 * wave + r) * 1536 + 512 + h * 64;
#pragma unroll
    for (int s = 0; s < 4; ++s) { const v4u v = *(const GAS v4u*)(kp + 16 * s + 8 * lh); *(LAS v4u*)(lds + MB_KF + ((wave * 4 + s) * 64 + lane) * 16) = v; }
    const bf16* vp = M.qkva + (kvrow0 + 32 * wave + r) * 1536 + 1024 + h * 64;
    P8 If;
#pragma unroll
    for (int q = 0; q < 8; ++q) { const int i0 = 2 * q, i1 = 2 * q + 1;
        const unsigned lo = ((i0 & 3) + 8 * (i0 >> 2) + 4 * lh == r) ? 0x3f80u : 0u, hi = ((i1 & 3) + 8 * (i1 >> 2) + 4 * lh == r) ? 0x3f800000u : 0u; If.w[q] = lo | hi; }
#pragma unroll
    for (int dt = 0; dt < 2; ++dt) { P8 vct;
#pragma unroll
        for (int g = 0; g < 4; ++g) { const u32x2_t v = *(const GAS u32x2_t*)(vp + 32 * dt + 8 * g + 4 * lh); vct.w[2 * g] = v.x; vct.w[2 * g + 1] = v.y; }
        const P8 vc = pack_tile(mm1(vct, If, zero16()));
        *(LAS u32x4_t*)(lds + MB_VF + (((wave * 2 + dt) * 2 + 0) * 64 + lane) * 16) = (u32x4_t){vc.w[0], vc.w[1], vc.w[2], vc.w[3]};
        *(LAS u32x4_t*)(lds + MB_VF + (((wave * 2 + dt) * 2 + 1) * 64 + lane) * 16) = (u32x4_t){vc.w[4], vc.w[5], vc.w[6], vc.w[7]}; }
}

template <bool CAUSAL> __device__ __forceinline__ void moba_scores(f32x16 (&St)[8], const bf16x8_t (&Qf)[4], LAS unsigned char* lds, int nkt, float slope2, float cq, int lim, int lane) {
    const int lh = lane >> 5;
#pragma unroll
    for (int kt = 0; kt < 8; ++kt) {
        if (kt < nkt) { f32x16 acc = zero16();
#pragma unroll
            for (int s = 0; s < 4; ++s) { const bf16x8_t kf = *(const LAS bf16x8_t*)(lds + MB_KF + ((kt * 4 + s) * 64 + lane) * 16); acc = MFMA32(kf, Qf[s], acc); }
#pragma unroll
            for (int i = 0; i < 16; ++i) { const int key = 32 * kt + (i & 3) + 8 * (i >> 2) + 4 * lh;
                float v = acc[i] * (0.125f * LOG2E) + (slope2 * (float)key + cq);
                if (CAUSAL) v = (key <= lim) ? v : -INFINITY;
                acc[i] = v; }
            St[kt] = acc; asm volatile("" ::: "memory"); }
        else {
#pragma unroll
            for (int i = 0; i < 16; ++i) St[kt][i] = -INFINITY; }
    }
}

__device__ __forceinline__ void moba_sel_unit(const MobaBufs& M, int unit, LAS unsigned char* lds, int tid, int lane_in, int wave) {
    int lane = lane_in; asm volatile("" : "+v"(lane));
    const int n = unit >> 6, bh = unit & 63, b = bh >> 3, h = bh & 7;
    const int r = lane & 31, lh = lane >> 5;
    LAS unsigned short* list = (LAS unsigned short*)(lds + MB_LIST); LAS unsigned* cntp = (LAS unsigned*)(lds + MB_CNT);
    __syncthreads();
    if (tid == 0) *cntp = 0u;
    __syncthreads();
    for (int t = 256 * (n + 1) + tid; t < SEQ; t += 512) { const unsigned s = M.sel[(size_t)bh * SEQ + t];
        const unsigned b0 = s & 0xffu, b1 = (s >> 8) & 0xffu, b2 = (s >> 16) & 0xffu;
        if (b0 == (unsigned)n || b1 == (unsigned)n || b2 == (unsigned)n) { const unsigned slot = (b0 == (unsigned)n) ? 0u : ((b1 == (unsigned)n) ? 1u : 2u);
            const unsigned idx = __hip_atomic_fetch_add(cntp, 1u, __ATOMIC_RELAXED, __HIP_MEMORY_SCOPE_WORKGROUP); list[idx] = (unsigned short)(t | (slot << 12)); } }
    moba_stage_kv(M, (size_t)b * SEQ + 256 * n, h, lds, wave, lane);
    __syncthreads();
    const int cnt = (int)*cntp;
    const float slope = exp2f(-(float)(h + 1)), slope2 = slope * LOG2E;
    for (int base = 0; base < cnt; base += 256) {
        const int qi = base + 32 * wave + r; const bool valid = qi < cnt;
        if (base + 32 * wave >= cnt) continue;
        const unsigned ent = list[valid ? qi : base + 32 * wave]; const int t = ent & 0xfff, slot = ent >> 12;
        const bf16* qp = M.qkva + ((size_t)b * SEQ + t) * 1536 + h * 64;
        bf16x8_t Qf[4];
#pragma unroll
        for (int s = 0; s < 4; ++s) Qf[s] = *(const GAS bf16x8_t*)(qp + 16 * s + 8 * lh);
        f32x16 St[8];
        float sl2 = slope2; int ln2 = lane; asm volatile("" : "+v"(sl2), "+v"(ln2));
        moba_scores<false>(St, Qf, lds, 8, sl2, sl2 * (float)(256 * n - t), 255, ln2);
        float mx = -INFINITY;
#pragma unroll
        for (int kt = 0; kt < 8; ++kt)
#pragma unroll
            for (int i = 0; i < 16; ++i) mx = fmaxf(mx, St[kt][i]);
        mx = fmaxf(mx, __shfl_xor(mx, 32));
        float ls = 0.f; f32x16 O[2] = {zero16(), zero16()};
#pragma unroll
        for (int kt = 0; kt < 8; ++kt) {
#pragma unroll
            for (int i = 0; i < 16; ++i) { const float p = __builtin_amdgcn_exp2f(St[kt][i] - mx); St[kt][i] = p; ls += p; }
            const P8 pp = pack_tile(St[kt]);
#pragma unroll
            for (int dt = 0; dt < 2; ++dt) {
                const bf16x8_t v0 = *(const LAS bf16x8_t*)(lds + MB_VF + (((kt * 2 + dt) * 2 + 0) * 64 + lane) * 16), v1 = *(const LAS bf16x8_t*)(lds + MB_VF + (((kt * 2 + dt) * 2 + 1) * 64 + lane) * 16);
                O[dt] = MFMA32(v0, frag<0>(pp), O[dt]); O[dt] = MFMA32(v1, frag<1>(pp), O[dt]); }
            asm volatile("" ::: "memory"); }
        ls += __shfl_xor(ls, 32);
        const float inv = 1.f / ls;
        if (valid) {
            bf16* rec = M.part + (((size_t)bh * SEQ + t) * 3 + slot) * 64;
#pragma unroll
            for (int dt = 0; dt < 2; ++dt)
#pragma unroll
                for (int g = 0; g < 4; ++g) { u32x2_t w; w.x = cvtpk(O[dt][4 * g] * inv, O[dt][4 * g + 1] * inv); w.y = cvtpk(O[dt][4 * g + 2] * inv, O[dt][4 * g + 3] * inv);
                    *(GAS u32x2_t*)(rec + 32 * dt + 8 * g + 4 * lh) = w; }
            if (lh == 0) { float* mlp = M.ml + (((size_t)bh * SEQ + t) * 3 + slot) * 2; mlp[0] = mx; mlp[1] = ls; }
        }
    }
}

__device__ __forceinline__ void moba_own_unit(const MobaBufs& M, int unit, LAS unsigned char* lds, int tid, int lane_in, int wave) {
    int lane = lane_in; asm volatile("" : "+v"(lane));
    const int qb = unit & 15, bh = unit >> 4, b = bh >> 3, h = bh & 7;
    const int r = lane & 31, lh = lane >> 5;
    __syncthreads();
    moba_stage_kv(M, (size_t)b * SEQ + 256 * qb, h, lds, wave, lane);
    __syncthreads();
    const float slope = exp2f(-(float)(h + 1)), slope2 = slope * LOG2E;
    const int tl = 32 * wave + r, t = 256 * qb + tl;
    const bf16* qp = M.qkva + ((size_t)b * SEQ + t) * 1536 + h * 64;
    bf16x8_t Qf[4];
#pragma unroll
    for (int s = 0; s < 4; ++s) Qf[s] = *(const GAS bf16x8_t*)(qp + 16 * s + 8 * lh);
    f32x16 St[8];
    moba_scores<true>(St, Qf, lds, wave + 1, slope2, -slope2 * (float)tl, tl, lane);
    float mx = -INFINITY;
#pragma unroll
    for (int kt = 0; kt < 8; ++kt)
#pragma unroll
        for (int i = 0; i < 16; ++i) mx = fmaxf(mx, St[kt][i]);
    mx = fmaxf(mx, __shfl_xor(mx, 32));
    const int nv = qb < 3 ? qb : 3;
    float ms[3], lsv[3]; float M2 = mx;
#pragma unroll
    for (int j = 0; j < 3; ++j) { ms[j] = -INFINITY; lsv[j] = 0.f;
        if (j < nv) { const float* mlp = M.ml + (((size_t)bh * SEQ + t) * 3 + j) * 2; ms[j] = mlp[0]; lsv[j] = mlp[1]; M2 = fmaxf(M2, ms[j]); } }
    float ls = 0.f; f32x16 O[2] = {zero16(), zero16()};
#pragma unroll
    for (int kt = 0; kt < 8; ++kt) {
        if (kt <= wave) {
#pragma unroll
            for (int i = 0; i < 16; ++i) { const float p = __builtin_amdgcn_exp2f(St[kt][i] - M2); St[kt][i] = p; ls += p; }
            const P8 pp = pack_tile(St[kt]);
#pragma unroll
            for (int dt = 0; dt < 2; ++dt) {
                const bf16x8_t v0 = *(const LAS bf16x8_t*)(lds + MB_VF + (((kt * 2 + dt) * 2 + 0) * 64 + lane) * 16), v1 = *(const LAS bf16x8_t*)(lds + MB_VF + (((kt * 2 + dt) * 2 + 1) * 64 + lane) * 16);
                O[dt] = MFMA32(v0, frag<0>(pp), O[dt]); O[dt] = MFMA32(v1, frag<1>(pp), O[dt]); }
            asm volatile("" ::: "memory"); }
    }
    ls += __shfl_xor(ls, 32);
#pragma unroll
    for (int j = 0; j < 3; ++j) {
        if (j < nv) { const float wj = lsv[j] * __builtin_amdgcn_exp2f(ms[j] - M2); ls += wj;
            const bf16* rec = M.part + (((size_t)bh * SEQ + t) * 3 + j) * 64;
#pragma unroll
            for (int dt = 0; dt < 2; ++dt)
#pragma unroll
                for (int g = 0; g < 4; ++g) { const u32x2_t w = *(const GAS u32x2_t*)(rec + 32 * dt + 8 * g + 4 * lh);
                    O[dt][4 * g] += wj * bflo(w.x); O[dt][4 * g + 1] += wj * bfhi(w.x); O[dt][4 * g + 2] += wj * bflo(w.y); O[dt][4 * g + 3] += wj * bfhi(w.y); } } }
    const float inv = 1.f / ls;
    const bf16* gp = M.gates + ((size_t)b * SEQ + t) * 1024 + 512 + h * 64;
    bf16* yp = M.ybuf + ((size_t)b * SEQ + t) * DM + 512 + h * 64;
#pragma unroll
    for (int dt = 0; dt < 2; ++dt)
#pragma unroll
        for (int g = 0; g < 4; ++g) { const u32x2_t gw = *(const GAS u32x2_t*)(gp + 32 * dt + 8 * g + 4 * lh);
            const float gg[4] = {bflo(gw.x), bfhi(gw.x), bflo(gw.y), bfhi(gw.y)}; float o[4];
#pragma unroll
            for (int e = 0; e < 4; ++e) o[e] = O[dt][4 * g + e] * inv * gg[e] * __builtin_amdgcn_rcpf(1.f + __expf(-gg[e]));
            u32x2_t w; w.x = cvtpk(o[0], o[1]); w.y = cvtpk(o[2], o[3]);
            *(GAS u32x2_t*)(yp + 32 * dt + 8 * g + 4 * lh) = w; }
}

__device__ __forceinline__ void phase_wdad(const Args& a, int tid) {
    const bf16* src = (const bf16*)(a.ws + WS_WDAD); bf16* dst = (bf16*)(a.ws + WS_WDAD2); const float* mu = a.in[3] + 1536;
    for (int it = blockIdx.x * 512 + tid; it < MTOK * 16; it += gridDim.x * 512) {
        const int m = it >> 4, ch = it & 15, t = m % SEQ;
        const v4u cv = *(const GAS v4u*)(src + (size_t)m * 128 + ch * 8); v4u pv = {0u, 0u, 0u, 0u};
        if (t > 0) pv = *(const GAS v4u*)(src + (size_t)(m - 1) * 128 + ch * 8);
        const f32x4 m0 = *(const GAS f32x4*)(mu + ch * 8), m1 = *(const GAS f32x4*)(mu + ch * 8 + 4);
        float o[8];
#pragma unroll
        for (int q = 0; q < 4; ++q) { const unsigned cw = cv[q], pw = pv[q];
            const float c0 = bflo(cw), c1 = bfhi(cw), p0 = bflo(pw), p1 = bfhi(pw);
            const float ma = (q < 2) ? m0[2 * q] : m1[2 * q - 4], mb = (q < 2) ? m0[2 * q + 1] : m1[2 * q - 3];
            o[2 * q] = c0 + (p0 - c0) * ma; o[2 * q + 1] = c1 + (p1 - c1) * mb; }
        if (ch < 8) {
#pragma unroll
            for (int q = 0; q < 8; ++q) o[q] = 1.f - 2.f * __builtin_amdgcn_rcpf(1.f + __expf(2.f * o[q]));
        }
        v4u ov = {cvtpk(o[0], o[1]), cvtpk(o[2], o[3]), cvtpk(o[4], o[5]), cvtpk(o[6], o[7])};
        *(GAS v4u*)(dst + (size_t)m * 128 + ch * 8) = ov;
    }
}

struct EpiSplit {
    static constexpr bool PERM = true, AFTER_DRAIN = false;
    bf16 *rkv, *qkva, *gates, *wdad;
    __device__ __forceinline__ void operator()(const pg8::f32x4 (&acc)[2][2][4][2], const pg8::Unit& u, int wr, int wc, int fr, int fq) const {
        const int pn = u.pn; bf16* base; int ldc, colt;
        if (pn < 6) { base = rkv; ldc = 1536; colt = pn * 256; } else if (pn < 12) { base = qkva; ldc = 1536; colt = (pn - 6) * 256; }
        else if (pn < 16) { base = gates; ldc = 1024; colt = (pn - 12) * 256; } else { base = wdad; ldc = 128; colt = 0; }
        const int row0 = u.pm * pg8::BM + wr * 64 + fr, col0 = colt + wc * 32 + 8 * fq;
#pragma unroll
        for (int ai = 0; ai < 2; ++ai)
#pragma unroll
            for (int m = 0; m < 4; ++m) { bf16* rowp = base + (size_t)(row0 + ai * pg8::HALF + m * 16) * ldc + col0;
#pragma unroll
                for (int bj = 0; bj < 2; ++bj) { if (pn == 16 && bj == 1) continue;
                    const pg8::f32x4 v0 = acc[ai][bj][m][0], v1 = acc[ai][bj][m][1];
                    pg8::u32x4 w; w.x = pg8::cvt_pk_bf16(v0[0], v0[1]); w.y = pg8::cvt_pk_bf16(v0[2], v0[3]); w.z = pg8::cvt_pk_bf16(v1[0], v1[1]); w.w = pg8::cvt_pk_bf16(v1[2], v1[3]);
                    *(pg8::u32x4*)(rowp + bj * pg8::HALF) = w; } }
    }
};
__global__ void __launch_bounds__(NWAVES * 64, 2) k_fused(Args a) {
    extern __shared__ __attribute__((aligned(16))) unsigned char lds_raw[];
    LAS unsigned char* lds = (LAS unsigned char*)lds_raw;
    volatile LAS unsigned* MISC = (volatile LAS unsigned*)(lds + MISC_OFF);
    const int tid = threadIdx.x, lane = tid & 63, wave = __builtin_amdgcn_readfirstlane(tid >> 6);
    gu32* ctl = (gu32*)(a.ws + WS_CTL);
    for (int u = tid; u < (LDS_BYTES - LDSCTL_OFF) / 4; u += NWAVES * 64) ((LAS unsigned*)(lds + LDSCTL_OFF))[u] = 0u;
    __syncthreads();
    XcdBarrier bar = xcd_barrier_post((unsigned*)(ctl + CW_BAR), MISC + 8);

#define NREP(k) ((PROBE_REP == (k)) ? 2 : 1)
    RwkvBufs RB{(const bf16*)(a.ws + WS_RKV), (const bf16*)(a.ws + WS_WDAD2), (bf16*)(a.ws + WS_MF), (bf16*)(a.ws + WS_NA), (bf16*)(a.ws + WS_PF), (bf16*)(a.ws + WS_QA), (bf16*)(a.ws + WS_BV),
                (const bf16*)(a.ws + WS_W2T), (const bf16*)(a.ws + WS_A2T)};
    MobaBufs MB{(const bf16*)(a.ws + WS_QKVA), (const float*)(a.ws + WS_KMEAN), (unsigned*)(a.ws + WS_SEL), (bf16*)(a.ws + WS_PART), (float*)(a.ws + WS_ML), (const bf16*)(a.ws + WS_GATES), (bf16*)(a.ws + WS_YBUF)};
    _Pragma("unroll") for (int rep = 0; rep < NREP(0); ++rep) {
    phase_prologue(a, lds, tid, lane, wave);
    xcd_barrier(bar); }
    _Pragma("unroll") for (int rep = 0; rep < NREP(1); ++rep) {
    {
        pg8::Gemm g{(const pg8::bf16_t*)(a.ws + WS_XN), (const pg8::bf16_t*)(a.ws + WS_WIN), MTOK, NPROJ_PAD, DM};
        pg8::StaticOrder S; S.init(MTOK, NPROJ_PAD, gridDim.x, (int)blockIdx.x);
        EpiSplit E{(bf16*)(a.ws + WS_RKV), (bf16*)(a.ws + WS_QKVA), (bf16*)(a.ws + WS_GATES), (bf16*)(a.ws + WS_WDAD)};
        pg8::gemm_phase<EpiSplit, pg8::StaticOrder, true, true>(lds + RING_OFF, g, S, E);
    }
    xcd_barrier(bar); }
    _Pragma("unroll") for (int rep = 0; rep < NREP(2); ++rep) {
    phase_kmean(a, tid);
    phase_wdad(a, tid);
    xcd_barrier(bar); }
    _Pragma("unroll") for (int rep = 0; rep < NREP(3); ++rep) {
    {
        for (int u = blockIdx.x; u < BATCH * NH * 8; u += gridDim.x) moba_gate_unit(MB, u, lds + RING_OFF, tid);
        __syncthreads();
        LAS float* pt = (LAS float*)(lds + RING_OFF);
        for (int i = tid; i < PT_FLOATS; i += NWAVES * 64) { float v;
            if (i < PT_W0) v = a.in[3][i]; else if (i < PT_A0) v = a.in[4][i - PT_W0]; else if (i < PT_KK) v = a.in[6][i - PT_A0]; else if (i < PT_KA) v = a.in[8][i - PT_KK];
            else if (i < PT_RK) v = a.in[9][i - PT_KA]; else v = a.in[10][i - PT_RK];
            pt[i] = v; }
        __syncthreads();
        LAS unsigned char* wl = lds + RING_OFF + PREP_PT_BYTES + wave * PREP_WAVE_BYTES;
        for (int u = blockIdx.x * NWAVES + wave; u < RW_NUNITS; u += gridDim.x * NWAVES) rwkv_prep_unit(RB, u, wl, pt, lane);
    }
    xcd_barrier(bar); }
    _Pragma("unroll") for (int rep = 0; rep < NREP(4); ++rep) {
    {
        if (rep == 0 && blockIdx.x < BATCH * NH) rwkv_seq_block(RB, (int)blockIdx.x, lds + RING_OFF, wave, lane);
        LAS unsigned* qslot = (LAS unsigned*)(lds + RING_OFF + MB_CNT + 64);
        for (;;) {
            __syncthreads();
            if (tid == 0) *qslot = __hip_atomic_fetch_add((unsigned*)(ctl + CW_QUEUE + 64 * rep), 1u, __ATOMIC_RELAXED, __HIP_MEMORY_SCOPE_AGENT);
            __syncthreads();
            const unsigned u = *qslot;
            if (u >= (unsigned)(15 * BATCH * NH)) break;
            moba_sel_unit(MB, (int)u, lds + RING_OFF, tid, lane, wave);
        }
    }
    xcd_barrier(bar); }
    _Pragma("unroll") for (int rep = 0; rep < NREP(5); ++rep) {
    for (int u = blockIdx.x * NWAVES + wave; u < RW_NUNITS; u += gridDim.x * NWAVES)
        rwkv_post_unit(RB, (const bf16*)(a.ws + WS_GATES), a.in[11], a.in[12], (bf16*)(a.ws + WS_YBUF), u, lane);
    for (int u = blockIdx.x; u < BATCH * NH * 16; u += gridDim.x) moba_own_unit(MB, u, lds + RING_OFF, tid, lane, wave);
    xcd_barrier(bar); }
    _Pragma("unroll") for (int rep = 0; rep < NREP(6); ++rep) {
    {
        pg8::Gemm g{(const pg8::bf16_t*)(a.ws + WS_YBUF), (const pg8::bf16_t*)(a.ws + WS_WOUT), MTOK, DM, DM};
        pg8::StaticOrder S; S.init(MTOK, DM, gridDim.x, (int)blockIdx.x);
        pg8::EpiF32 E{(float*)(a.ws + WS_OBUF), DM, nullptr};
        pg8::gemm_phase<pg8::EpiF32, pg8::StaticOrder, true, true>(lds + RING_OFF, g, S, E);
    }
    xcd_barrier(bar); }
    _Pragma("unroll") for (int rep = 0; rep < NREP(7); ++rep) {
    phase_final(a, lane, wave);
    if (rep + 1 < NREP(7)) xcd_barrier(bar); }
}

extern "C" void kernel_launch(void* const* d_in, const int* in_sizes, int n_in, void* d_out, int out_size, void* d_ws, size_t ws_size, hipStream_t stream) {
    static int grid = 0;
    if (grid == 0) {
        if (n_in != 15 || in_sizes[0] != MTOK * DM || out_size != MTOK * DM || ws_size < WS_END) { fprintf(stderr, "kernel_launch: bad shapes n_in %d in0 %d out %d ws %zu\n", n_in, n_in > 0 ? in_sizes[0] : -1, out_size, ws_size); grid = -1; return; }
        int dev = 0, cus = 0, per_cu = 0;
        if (hipGetDevice(&dev) != hipSuccess || hipDeviceGetAttribute(&cus, hipDeviceAttributeMultiprocessorCount, dev) != hipSuccess) { grid = -1; return; }
        if (hipFuncSetAttribute((const void*)k_fused, hipFuncAttributeMaxDynamicSharedMemorySize, LDS_BYTES) != hipSuccess) { grid = -1; return; }
        if (hipOccupancyMaxActiveBlocksPerMultiprocessor(&per_cu, (const void*)k_fused, NWAVES * 64, LDS_BYTES) != hipSuccess || per_cu < 1) { fprintf(stderr, "kernel_launch: occupancy query says %d\n", per_cu); }
        (void)hipGetLastError();
        grid = cus;
    }
    if (grid < 0) return;
    if (hipMemsetAsync((char*)d_ws + WS_CTL, 0, CTL_ZERO_BYTES, stream) != hipSuccess) return;
    Args a{};
    for (int i = 0; i < 15; ++i) a.in[i] = (const float*)d_in[i];
    a.out = (float*)d_out; a.ws = (unsigned char*)d_ws;
    hipLaunchKernelGGL(k_fused, dim3(grid), dim3(NWAVES * 64), LDS_BYTES, stream, a);
}
```
